# Optimizing an MI355X kernel written in HIP

```python
import functools
import jax, jax.numpy as jnp
from jax import lax
import numpy as np

D_MODEL = 1024
BATCH = 8
SEQ = 2048
DEPTH = 2

GRID_W = 64
CTX_LEN = 256
N_FGROUPS = 4
FGROUP_DIM = 128
F_WIDTH = N_FGROUPS * FGROUP_DIM
HEAD_DIM = 64
N_RHEADS = 8
R_WIDTH = N_RHEADS * HEAD_DIM
D_DECAY_LORA = 64
D_AAA_LORA = 64
D_GATE_LORA = 128
N_DIRS = 2
D_FF = 4 * D_MODEL
RWKV_IN = 3 * R_WIDTH + N_DIRS * (D_DECAY_LORA + D_AAA_LORA) + D_GATE_LORA
IN_WIDTH = F_WIDTH + RWKV_IN + 2 * D_MODEL
N_MOD = 6
NORM_EPS = 1e-6
GN_EPS = 64e-5
L2_EPS = 1e-12
RWKV_SPLITS = [R_WIDTH, 2 * R_WIDTH, 3 * R_WIDTH,
               3 * R_WIDTH + D_DECAY_LORA,
               3 * R_WIDTH + 2 * D_DECAY_LORA,
               3 * R_WIDTH + 2 * D_DECAY_LORA + D_AAA_LORA,
               3 * R_WIDTH + 2 * D_DECAY_LORA + 2 * D_AAA_LORA]

kernel_name = "hybrid_fourier_rwkv7_dit_prefix"


def rms_norm(x, g):
    x32 = x.astype(jnp.float32)
    y = x32 * lax.rsqrt(jnp.mean(x32 * x32, axis=-1, keepdims=True) + NORM_EPS)
    return (y * g.astype(jnp.float32)).astype(x.dtype)


def grid_shift(u):
    b, l, ch = u.shape
    rows = l // GRID_W
    q = u.reshape(b, rows, GRID_W, 4, ch // 4)
    left = jnp.pad(q[:, :, :-1, 0], ((0, 0), (0, 0), (1, 0), (0, 0)))
    right = jnp.pad(q[:, :, 1:, 1], ((0, 0), (0, 0), (0, 1), (0, 0)))
    up = jnp.pad(q[:, :-1, :, 2], ((0, 0), (1, 0), (0, 0), (0, 0)))
    down = jnp.pad(q[:, 1:, :, 3], ((0, 0), (0, 1), (0, 0), (0, 0)))
    return jnp.stack([left, right, up, down], axis=3).reshape(b, l, ch)


def seq_shift(u):
    b, l, ch = u.shape
    q = u.reshape(b, l, 2, ch // 2)
    prev = jnp.pad(q[:, :-1, 0], ((0, 0), (1, 0), (0, 0)))
    nxt = jnp.pad(q[:, 1:, 1], ((0, 0), (0, 1), (0, 0)))
    return jnp.stack([prev, nxt], axis=2).reshape(b, l, ch)


def fourier_mix(u):
    b, l, _ = u.shape
    ug = u.astype(jnp.float32).reshape(b, l, N_FGROUPS, FGROUP_DIM)
    f = jnp.fft.fft2(ug, axes=(1, 3), norm="ortho").real
    return f.reshape(b, l, F_WIDTH).astype(u.dtype)


def rwkv_scan(r, k, v, w, kk, a, s0):
    def step(s, inp):
        r_t, k_t, v_t, w_t, kk_t, a_t = inp
        sa = jnp.einsum('dbhvk,dbhk->dbhv', s, kk_t)
        s = (s * w_t[..., None, :] - sa[..., :, None] * (kk_t * a_t)[..., None, :]
             + v_t[..., :, None] * k_t[..., None, :])
        y = jnp.einsum('dbhvk,dbhk->dbhv', s, r_t)
        return s, y
    xs = tuple(jnp.moveaxis(t.astype(jnp.float32), 2, 0) for t in (r, k, v, w, kk, a))
    s_final, ys = lax.scan(step, s0, xs)
    return jnp.moveaxis(ys, 0, 2), s_final


def _dir_seq(t):
    return jnp.stack([t[0], jnp.flip(t[1], axis=1)], axis=0)


def _both(t):
    return jnp.stack([t, jnp.flip(t, axis=1)], axis=0)


def token_mixer(h, s0, shift_fn, need_out, w_in, mu_shift, w0, w_up, a0, a_up, g_up,
                k_k, k_a, r_k, ln_x_w, ln_x_b, w_fourier_up, w_rwkv_up, w_out):
    b, l, _ = h.shape
    proj = h @ w_in
    f_in = proj[..., :F_WIDTH]
    rw = proj[..., F_WIDTH:F_WIDTH + RWKV_IN]
    gates = proj[..., F_WIDTH + RWKV_IN:]
    rw = rw + mu_shift * (shift_fn(rw) - rw)
    r, k, v, wd_f, wd_b, ad_f, ad_b, gd = jnp.split(rw, RWKV_SPLITS, axis=-1)
    wd = jnp.stack([wd_f, wd_b], axis=0)
    ad = jnp.stack([ad_f, ad_b], axis=0)
    w_logit = w0[:, None, None, :] + jnp.einsum('dblr,drc->dblc', jnp.tanh(wd), w_up)
    decay = jnp.exp(-jnp.exp((-jax.nn.softplus(-w_logit) - 0.5).astype(jnp.float32)))
    a = jax.nn.sigmoid(a0[:, None, None, :] + jnp.einsum('dblr,drc->dblc', ad, a_up))
    k_dir = k[None] * (1 + (a - 1) * k_a)
    g = jax.nn.sigmoid(gd) @ g_up
    kk = (k * k_k).astype(jnp.float32).reshape(b, l, N_RHEADS, HEAD_DIM)
    kk = kk / jnp.maximum(jnp.sqrt(jnp.sum(kk * kk, axis=-1, keepdims=True)), L2_EPS)

    hd = lambda t: t.reshape(t.shape[:-1] + (N_RHEADS, HEAD_DIM))
    ys, s_final = rwkv_scan(_both(hd(r)), _dir_seq(hd(k_dir)), _both(hd(v)),
                            _dir_seq(hd(decay)), _both(kk), _dir_seq(hd(a)), s0)
    if not need_out:
        return None, s_final
    y = ys[0] + jnp.flip(ys[1], axis=1)
    mu = jnp.mean(y, axis=-1, keepdims=True)
    var = jnp.mean(jnp.square(y - mu), axis=-1, keepdims=True)
    yn = ((y - mu) * lax.rsqrt(var + GN_EPS)).reshape(b, l, R_WIDTH)
    yn = (yn * ln_x_w + ln_x_b).astype(h.dtype)
    bonus = jnp.sum(hd(r) * hd(k_dir[0] + k_dir[1]) * r_k, axis=-1, keepdims=True) * hd(v)
    rwkv_out = (yn + bonus.reshape(b, l, R_WIDTH)) * g
    f_out = fourier_mix(f_in)
    gate_f, gate_r = jnp.split(gates, 2, axis=-1)
    merged = (jax.nn.sigmoid(gate_f) * (f_out @ w_fourier_up)
              + jax.nn.sigmoid(gate_r) * (rwkv_out @ w_rwkv_up))
    return merged @ w_out, s_final


def sq_relu_mlp(h, w1, w2):
    return jnp.square(jax.nn.relu(h @ w1)) @ w2


def setup_inputs(seed: int = 0) -> dict:
    key = jax.random.key(seed)
    ks = jax.random.split(key, 32)
    nrm = lambda k, shape, s: jax.random.normal(k, shape, jnp.float32) * s
    return {
        "x": nrm(ks[0], (BATCH, SEQ, D_MODEL), 1.0),
        "c": nrm(ks[1], (BATCH, D_MODEL), 1.0),
        "ctx": nrm(ks[2], (BATCH, CTX_LEN, D_MODEL), 1.0),
        "c_ctx": nrm(ks[3], (D_MODEL,), 1.0),
        "w_mod": nrm(ks[4], (DEPTH, D_MODEL, N_MOD * D_MODEL), 0.5 * D_MODEL ** -0.5),
        "b_mod": nrm(ks[5], (DEPTH, N_MOD * D_MODEL), 0.02),
        "norm1": 1.0 + nrm(ks[6], (DEPTH, D_MODEL), 0.05),
        "norm2": 1.0 + nrm(ks[7], (DEPTH, D_MODEL), 0.05),
        "w_in": nrm(ks[8], (DEPTH, D_MODEL, IN_WIDTH), D_MODEL ** -0.5),
        "mu_shift": jax.random.uniform(ks[9], (DEPTH, RWKV_IN), jnp.float32),
        "w0": jax.random.uniform(ks[10], (DEPTH, N_DIRS, R_WIDTH), jnp.float32, -5.0, -0.5),
        "w_up": nrm(ks[11], (DEPTH, N_DIRS, D_DECAY_LORA, R_WIDTH), 0.5 * D_DECAY_LORA ** -0.5),
        "a0": nrm(ks[12], (DEPTH, N_DIRS, R_WIDTH), 0.3),
        "a_up": nrm(ks[13], (DEPTH, N_DIRS, D_AAA_LORA, R_WIDTH), 0.5 * D_AAA_LORA ** -0.5),
        "g_up": nrm(ks[14], (DEPTH, D_GATE_LORA, R_WIDTH), D_GATE_LORA ** -0.5),
        "k_k": 0.85 + nrm(ks[15], (DEPTH, R_WIDTH), 0.05),
        "k_a": 1.0 + nrm(ks[16], (DEPTH, R_WIDTH), 0.05),
        "r_k": nrm(ks[17], (DEPTH, N_RHEADS, HEAD_DIM), 0.1),
        "ln_x_w": 1.0 + nrm(ks[18], (DEPTH, R_WIDTH), 0.05),
        "ln_x_b": nrm(ks[19], (DEPTH, R_WIDTH), 0.02),
        "w_fourier_up": nrm(ks[20], (DEPTH, F_WIDTH, D_MODEL), F_WIDTH ** -0.5),
        "w_rwkv_up": nrm(ks[21], (DEPTH, R_WIDTH, D_MODEL), R_WIDTH ** -0.5),
        "w_out": nrm(ks[22], (DEPTH, D_MODEL, D_MODEL), D_MODEL ** -0.5),
        "mlp_w1": nrm(ks[23], (DEPTH, D_MODEL, D_FF), D_MODEL ** -0.5),
        "mlp_w2": nrm(ks[24], (DEPTH, D_FF, D_MODEL), D_FF ** -0.5),
        "norm_f": 1.0 + nrm(ks[25], (D_MODEL,), 0.05),
    }


def reference(x, c, ctx, c_ctx, w_mod, b_mod, norm1, norm2, w_in, mu_shift, w0, w_up, a0,
              a_up, g_up, k_k, k_a, r_k, ln_x_w, ln_x_b, w_fourier_up, w_rwkv_up, w_out,
              mlp_w1, mlp_w2, norm_f):
    x_lat, x_ctx = x, ctx
    s0 = jnp.zeros((N_DIRS, x.shape[0], N_RHEADS, HEAD_DIM, HEAD_DIM), jnp.float32)
    for l in range(DEPTH):
        last = l == DEPTH - 1
        mod = jax.nn.silu(c) @ w_mod[l] + b_mod[l]
        sh1, sc1, g1, sh2, sc2, g2 = jnp.split(mod[:, None, :], N_MOD, axis=-1)
        mod_c = jax.nn.silu(c_ctx) @ w_mod[l] + b_mod[l]
        ch1, cs1, cg1, ch2, cs2, cg2 = jnp.split(mod_c, N_MOD, axis=-1)
        mixer = functools.partial(
            token_mixer, w_in=w_in[l], mu_shift=mu_shift[l], w0=w0[l], w_up=w_up[l],
            a0=a0[l], a_up=a_up[l], g_up=g_up[l], k_k=k_k[l], k_a=k_a[l], r_k=r_k[l],
            ln_x_w=ln_x_w[l], ln_x_b=ln_x_b[l], w_fourier_up=w_fourier_up[l],
            w_rwkv_up=w_rwkv_up[l], w_out=w_out[l])
        h_c = rms_norm(x_ctx, norm1[l]) * (1 + cs1) + ch1
        out_c, s_ctx = mixer(h_c, s0, seq_shift, not last)
        h = rms_norm(x_lat, norm1[l]) * (1 + sc1) + sh1
        out, _ = mixer(h, s_ctx, grid_shift, True)
        x_lat = x_lat + g1 * out
        h = rms_norm(x_lat, norm2[l]) * (1 + sc2) + sh2
        x_lat = x_lat + g2 * sq_relu_mlp(h, mlp_w1[l], mlp_w2[l])
        if not last:
            x_ctx = x_ctx + cg1 * out_c
            h_c = rms_norm(x_ctx, norm2[l]) * (1 + cs2) + ch2
            x_ctx = x_ctx + cg2 * sq_relu_mlp(h_c, mlp_w1[l], mlp_w2[l])
    return rms_norm(x_lat, norm_f)
```

```cpp
#include <hip/hip_runtime.h>
#include <hip/hip_cooperative_groups.h>
#include <cstdio>
#include <cstdint>
#include <cstddef>
namespace cg = cooperative_groups;

typedef unsigned short u16;
typedef _Float16 f16;
using bf16x8 = __attribute__((ext_vector_type(8))) short;
using f32x4 = __attribute__((ext_vector_type(4))) float;
using f16x8 = __attribute__((ext_vector_type(8))) _Float16;
using f16x4 = __attribute__((ext_vector_type(4))) _Float16;
using u16x8 = __attribute__((ext_vector_type(8))) unsigned short;

#ifndef ONE_LAUNCH
#define ONE_LAUNCH 1
#endif

constexpr int D = 1024, NB = 8, L = 2048, LC = 256, TL = 16384, TC = 2048, TA = 18432;
constexpr int NTHREADS = 512;
constexpr int LDT = 72;
constexpr int STAGE_ELEMS = (256 + 128) * LDT;
constexpr int LDS_BYTES = 2 * STAGE_ELEMS * 2;

constexpr size_t MiB = (size_t)1 << 20;
constexpr size_t OFF_MOD = 0;
constexpr size_t OFF_XC = 1 * MiB;
constexpr size_t OFF_WTA = 9 * MiB;
constexpr size_t OFF_FIN = 23 * MiB;
constexpr size_t OFF_EH = 41 * MiB;
constexpr size_t OFF_RW = 77 * MiB;
constexpr size_t OFF_W1T = 77 * MiB;
constexpr size_t OFF_W2T = 85 * MiB;
constexpr size_t OFF_YS0 = 93 * MiB;
constexpr size_t OFF_YS1 = 111 * MiB;
constexpr size_t OFF_HID = 93 * MiB;
constexpr size_t OFF_R = 144 * MiB + MiB / 2;
constexpr size_t OFF_K = OFF_R + 18 * MiB;
constexpr size_t OFF_V = OFF_K + 18 * MiB;
constexpr size_t OFF_AR = OFF_V + 18 * MiB;
constexpr size_t OFF_LORA = OFF_AR + 36 * MiB;
constexpr size_t OFF_GDS = OFF_LORA + 9 * MiB;
constexpr size_t OFF_INVN = OFF_GDS + 4 * MiB + MiB / 2;
constexpr size_t WS_NEED = OFF_INVN + MiB;
constexpr size_t WO_IN = 0, WO_FU = 9175040, WO_RU = 10223616, WO_OUT = 11272192, WO_WUP = 13369344, WO_AUP = 13500416, WO_GUP = 13631488;
constexpr size_t DM_C = 0, DM_NS = (size_t)2048 * 2048, DM_CC = (size_t)2 * 2048 * 2048, DM_NSC = DM_CC + 65536, DM_TW = DM_NSC + 65536;

struct Params {
  const float *x, *c, *ctx, *c_ctx, *w_mod, *b_mod, *norm1, *norm2, *w_in, *mu_shift, *w0, *w_up, *a0, *a_up, *g_up,
      *k_k, *k_a, *r_k, *ln_x_w, *ln_x_b, *w_fourier_up, *w_rwkv_up, *w_out, *mlp_w1, *mlp_w2, *norm_f;
  float* out;
  char* ws;
  int ph_lo, ph_hi;
};
__device__ __forceinline__ char* WS(const Params& p) { int z = 0; asm volatile("" : "+s"(z)); return p.ws + z; }


__device__ __forceinline__ int TID() { int t = threadIdx.x; asm volatile("" : "+v"(t)); return t; }
__device__ __forceinline__ int BID() { int t = blockIdx.x; asm volatile("" : "+s"(t)); return t; }
__device__ __forceinline__ u16 f2bf(float f) {
  uint32_t u = __float_as_uint(f);
  u += 0x7fffu + ((u >> 16) & 1u);
  return (u16)(u >> 16);
}
__device__ __forceinline__ float bf2f(u16 h) { return __uint_as_float(((uint32_t)h) << 16); }
__device__ __forceinline__ float sigmoidf_(float x) { return 1.f / (1.f + __expf(-x)); }
__device__ __forceinline__ f16 f2h(float v) { v = fminf(fmaxf(v, -60000.f), 60000.f); return (f16)v; }

template <int CTRL>
__device__ __forceinline__ float dpp_f(float x) {
  return __int_as_float(__builtin_amdgcn_update_dpp(0, __float_as_int(x), CTRL, 0xf, 0xf, true));
}
__device__ __forceinline__ float red8(float x) {
  x += dpp_f<0xB1>(x);
  x += dpp_f<0x4E>(x);
  x += dpp_f<0x141>(x);
  return x;
}
__device__ __forceinline__ float wave_sum(float v) {
#pragma unroll
  for (int o = 32; o > 0; o >>= 1) v += __shfl_xor(v, o, 64);
  return v;
}

__device__ __forceinline__ void gemm_loop(f32x4 (&acc)[4][4], const u16* __restrict__ A, int lda,
                                          const u16* __restrict__ Bt, int ldb, int K, char* lds) {
  const int tid = TID();
  const int lane = tid & 63, wave = tid >> 6;
  const int wm = wave >> 1, wn = wave & 1;
  u16* s0 = (u16*)lds;
  const int lr = tid >> 3, lc = (tid & 7) * 8;
  const u16* ap0 = A + (size_t)lr * lda + lc;
  const u16* ap1 = ap0 + (size_t)64 * lda;
  const u16* ap2 = ap0 + (size_t)128 * lda;
  const u16* ap3 = ap0 + (size_t)192 * lda;
  const u16* bp0 = Bt + (size_t)lr * ldb + lc;
  const u16* bp1 = bp0 + (size_t)64 * ldb;
  const int KT = K >> 6;
  const int wofa = lr * LDT + lc;
  const int wofb = 256 * LDT + wofa;
  __syncthreads();
  uint4 ra0 = *(const uint4*)ap0, ra1 = *(const uint4*)ap1, ra2 = *(const uint4*)ap2, ra3 = *(const uint4*)ap3;
  uint4 rb0 = *(const uint4*)bp0, rb1 = *(const uint4*)bp1;
  *(uint4*)(s0 + wofa) = ra0;
  *(uint4*)(s0 + wofa + 64 * LDT) = ra1;
  *(uint4*)(s0 + wofa + 128 * LDT) = ra2;
  *(uint4*)(s0 + wofa + 192 * LDT) = ra3;
  *(uint4*)(s0 + wofb) = rb0;
  *(uint4*)(s0 + wofb + 64 * LDT) = rb1;
  __syncthreads();
  const int arow = (wm * 64 + (lane & 15)) * LDT + (lane >> 4) * 8;
  const int brow = (wn * 64 + (lane & 15)) * LDT + (lane >> 4) * 8;
  for (int kt = 0; kt < KT; ++kt) {
    const int s = kt & 1;
    const bool more = (kt + 1 < KT);
    if (more) {
      const int ko = (kt + 1) * 64;
      ra0 = *(const uint4*)(ap0 + ko); ra1 = *(const uint4*)(ap1 + ko);
      ra2 = *(const uint4*)(ap2 + ko); ra3 = *(const uint4*)(ap3 + ko);
      rb0 = *(const uint4*)(bp0 + ko); rb1 = *(const uint4*)(bp1 + ko);
    }
    const u16* sa = s0 + s * STAGE_ELEMS;
    const u16* sb = sa + 256 * LDT;
#pragma unroll
    for (int ks = 0; ks < 2; ++ks) {
      const bf16x8 a0 = *(const bf16x8*)(sa + arow + ks * 32);
      const bf16x8 a1 = *(const bf16x8*)(sa + arow + 16 * LDT + ks * 32);
      const bf16x8 a2 = *(const bf16x8*)(sa + arow + 32 * LDT + ks * 32);
      const bf16x8 a3 = *(const bf16x8*)(sa + arow + 48 * LDT + ks * 32);
      const bf16x8 b0 = *(const bf16x8*)(sb + brow + ks * 32);
      const bf16x8 b1 = *(const bf16x8*)(sb + brow + 16 * LDT + ks * 32);
      const bf16x8 b2 = *(const bf16x8*)(sb + brow + 32 * LDT + ks * 32);
      const bf16x8 b3 = *(const bf16x8*)(sb + brow + 48 * LDT + ks * 32);
#define MF(i, j, av, bv) acc[i][j] = __builtin_amdgcn_mfma_f32_16x16x32_bf16(av, bv, acc[i][j], 0, 0, 0)
      MF(0, 0, a0, b0); MF(0, 1, a0, b1); MF(0, 2, a0, b2); MF(0, 3, a0, b3);
      MF(1, 0, a1, b0); MF(1, 1, a1, b1); MF(1, 2, a1, b2); MF(1, 3, a1, b3);
      MF(2, 0, a2, b0); MF(2, 1, a2, b1); MF(2, 2, a2, b2); MF(2, 3, a2, b3);
      MF(3, 0, a3, b0); MF(3, 1, a3, b1); MF(3, 2, a3, b2); MF(3, 3, a3, b3);
#undef MF
    }
    if (more) {
      u16* w = s0 + (s ^ 1) * STAGE_ELEMS;
      *(uint4*)(w + wofa) = ra0;
      *(uint4*)(w + wofa + 64 * LDT) = ra1;
      *(uint4*)(w + wofa + 128 * LDT) = ra2;
      *(uint4*)(w + wofa + 192 * LDT) = ra3;
      *(uint4*)(w + wofb) = rb0;
      *(uint4*)(w + wofb + 64 * LDT) = rb1;
    }
    __syncthreads();
  }
}

__device__ __forceinline__ void acc_zero(f32x4 (&acc)[4][4]) {
#pragma unroll
  for (int i = 0; i < 4; ++i)
#pragma unroll
    for (int j = 0; j < 4; ++j) acc[i][j] = f32x4{0.f, 0.f, 0.f, 0.f};
}

template <class F>
__device__ __forceinline__ void epi_apply(f32x4 (&acc)[4][4], char* lds, F f) {
  const int lane = TID() & 63, wave = TID() >> 6;
  const int wm = wave >> 1, wn = wave & 1;
  float* sw = (float*)lds + wave * (32 * 68);
#pragma unroll
  for (int hp = 0; hp < 2; ++hp) {
#pragma unroll
    for (int m2 = 0; m2 < 2; ++m2)
#pragma unroll
      for (int nf = 0; nf < 4; ++nf)
#pragma unroll
        for (int r = 0; r < 4; ++r)
          sw[(m2 * 16 + (lane >> 4) * 4 + r) * 68 + nf * 16 + (lane & 15)] = acc[hp * 2 + m2][nf][r];
    __builtin_amdgcn_wave_barrier();
#pragma unroll
    for (int i = 0; i < 4; ++i) {
      const int rr = i * 8 + (lane >> 3), cc = (lane & 7) * 8;
      const float4 a = *(const float4*)(sw + rr * 68 + cc), b = *(const float4*)(sw + rr * 68 + cc + 4);
      float v[8] = {a.x, a.y, a.z, a.w, b.x, b.y, b.z, b.w};
      f(wm * 64 + hp * 32 + rr, wn * 64 + cc, v);
    }
    __builtin_amdgcn_wave_barrier();
  }
}

__device__ __forceinline__ u16x8 pack_bf8(const float (&v)[8]) {
  u16x8 o;
#pragma unroll
  for (int j = 0; j < 8; ++j) o[j] = f2bf(v[j]);
  return o;
}
__device__ __forceinline__ f16x8 pack_h8(const float (&v)[8]) {
  f16x8 o;
#pragma unroll
  for (int j = 0; j < 8; ++j) o[j] = f2h(v[j]);
  return o;
}

__device__ void copy_f4(const float* __restrict__ src, float* __restrict__ dst, size_t n4) {
  const float4* s = (const float4*)src; float4* d = (float4*)dst;
  for (size_t i = (size_t)BID() * NTHREADS + TID(); i < n4; i += (size_t)gridDim.x * NTHREADS) d[i] = s[i];
}

__device__ void mod_phase(const Params& p, char* lds) {
  float* sl = (float*)lds;
  float* red = sl + 9 * 1024;
  float* MOD = (float*)(WS(p) + OFF_MOD);
  const int tid = TID(), lane = tid & 63, wave = tid >> 6;
  __syncthreads();
  for (int i = tid; i < 9 * 1024; i += NTHREADS) {
    float v = (i < 8 * 1024) ? p.c[i] : p.c_ctx[i - 8 * 1024];
    sl[i] = v * sigmoidf_(v);
  }
  __syncthreads();
  for (int item = BID(); item < 192; item += gridDim.x) {
    const int l = item / 96, n0 = (item % 96) * 64;
    const float* w = p.w_mod + (size_t)l * 1024 * 6144 + n0 + lane;
    float acc[9];
#pragma unroll
    for (int r = 0; r < 9; ++r) acc[r] = 0.f;
    const int kbeg = wave * 128;
#pragma unroll 8
    for (int k = kbeg; k < kbeg + 128; ++k) {
      float wv = w[(size_t)k * 6144];
#pragma unroll
      for (int r = 0; r < 9; ++r) acc[r] += sl[r * 1024 + k] * wv;
    }
#pragma unroll
    for (int r = 0; r < 9; ++r) red[(wave * 9 + r) * 64 + lane] = acc[r];
    __syncthreads();
    for (int i = tid; i < 9 * 64; i += NTHREADS) {
      int r = i >> 6, ln = i & 63;
      float s = 0.f;
#pragma unroll
      for (int w8 = 0; w8 < 8; ++w8) s += red[(w8 * 9 + r) * 64 + ln];
      MOD[((size_t)l * 9 + r) * 6144 + n0 + ln] = s + p.b_mod[(size_t)l * 6144 + n0 + ln];
    }
    __syncthreads();
  }
}

__device__ void convT_tile(const float* __restrict__ src, int K, int N, u16* __restrict__ dst, int t, char* lds) {
  float* tile = (float*)lds;
  const int tid = TID();
  const int nT = N >> 6;
  const int k0 = (t / nT) * 64, n0 = (t % nT) * 64;
  __syncthreads();
#pragma unroll
  for (int i = 0; i < 8; ++i) {
    int k = (tid >> 6) + 8 * i, n = tid & 63;
    tile[k * 65 + n] = src[(size_t)(k0 + k) * N + n0 + n];
  }
  __syncthreads();
  {
    int n = tid >> 3, kc = (tid & 7) * 8;
    u16x8 o;
#pragma unroll
    for (int j = 0; j < 8; ++j) o[j] = f2bf(tile[(kc + j) * 65 + n]);
    *(u16x8*)(dst + (size_t)(n0 + n) * K + k0 + kc) = o;
  }
}

__device__ void conv_phase(const Params& p, int l, int set, char* lds) {
  char* wta = WS(p) + OFF_WTA;
  const int total = (set == 0) ? 1680 : 2048;
  for (int t = BID(); t < total; t += gridDim.x) {
    int tt = t;
    const float* src; int K, N; u16* dst;
    if (set == 0) {
      if (tt < 1120) { src = p.w_in + (size_t)l * 1024 * 4480; K = 1024; N = 4480; dst = (u16*)(wta + WO_IN); }
      else if ((tt -= 1120) < 128) { src = p.w_fourier_up + (size_t)l * 512 * 1024; K = 512; N = 1024; dst = (u16*)(wta + WO_FU); }
      else if ((tt -= 128) < 128) { src = p.w_rwkv_up + (size_t)l * 512 * 1024; K = 512; N = 1024; dst = (u16*)(wta + WO_RU); }
      else if ((tt -= 128) < 256) { src = p.w_out + (size_t)l * 1024 * 1024; K = 1024; N = 1024; dst = (u16*)(wta + WO_OUT); }
      else if ((tt -= 256) < 16) { const int d = tt >> 3; tt &= 7; src = p.w_up + (size_t)(l * 2 + d) * 64 * 512; K = 64; N = 512; dst = (u16*)(wta + WO_WUP) + d * 512 * 64; }
      else if ((tt -= 16) < 16) { const int d = tt >> 3; tt &= 7; src = p.a_up + (size_t)(l * 2 + d) * 64 * 512; K = 64; N = 512; dst = (u16*)(wta + WO_AUP) + d * 512 * 64; }
      else { tt -= 16; src = p.g_up + (size_t)l * 128 * 512; K = 128; N = 512; dst = (u16*)(wta + WO_GUP); }
    } else {
      if (tt < 1024) { src = p.mlp_w1 + (size_t)l * 1024 * 4096; K = 1024; N = 4096; dst = (u16*)(WS(p) + OFF_W1T); }
      else { tt -= 1024; src = p.mlp_w2 + (size_t)l * 4096 * 1024; K = 4096; N = 1024; dst = (u16*)(WS(p) + OFF_W2T); }
    }
    convT_tile(src, K, N, dst, tt, lds);
  }
}

__device__ void dftm_gen(const Params& p) {
  u16* DM = (u16*)(WS(p) + OFF_AR);
  const size_t gt = (size_t)BID() * NTHREADS + TID(), gs = (size_t)gridDim.x * NTHREADS;
  const float TWO_PI = 6.283185307179586f;
  for (size_t i = gt; i < (size_t)2048 * 2048; i += gs) {
    int k = (int)(i >> 11), l = (int)(i & 2047);
    int m = (k * l) & 2047;
    float s, c;
    sincosf(TWO_PI * (float)m * (1.f / 2048.f), &s, &c);
    DM[DM_C + i] = f2bf(c);
    DM[DM_NS + i] = f2bf(-s);
  }
  for (size_t i = gt; i < (size_t)256 * 256; i += gs) {
    int k = (int)(i >> 8), l = (int)(i & 255);
    int m = (k * l) & 255;
    float s, c;
    sincosf(TWO_PI * (float)m * (1.f / 256.f), &s, &c);
    DM[DM_CC + i] = f2bf(c);
    DM[DM_NSC + i] = f2bf(-s);
  }
  for (size_t i = gt; i < (size_t)256 * 128; i += gs) {
    int row = (int)(i >> 7), cch = (int)(i & 127);
    int j = row & 127;
    int m = (j * cch) & 127;
    float s, c;
    sincosf(TWO_PI * (float)m * (1.f / 128.f), &s, &c);
    DM[DM_TW + i] = f2bf(row < 128 ? c : s);
  }
}

__device__ void normmod_phase(const Params& p, int l, int which, int ntok, u16* __restrict__ H) {
  const float* MOD = (const float*)(WS(p) + OFF_MOD);
  const float* XC = (const float*)(WS(p) + OFF_XC);
  const float* nw = (which == 0 ? p.norm1 : p.norm2) + l * 1024;
  const int lane = TID() & 63;
  const int gw = BID() * 8 + (TID() >> 6), nw_ = gridDim.x * 8;
  for (int t = gw; t < ntok; t += nw_) {
    const float* xr = (t < TL) ? (p.out + (size_t)t * 1024) : (XC + (size_t)(t - TL) * 1024);
    const int mrow = (t < TL) ? (t >> 11) : 8;
    const float* mo = MOD + ((size_t)l * 9 + mrow) * 6144 + which * 3072;
    float4 v[4];
    float ss = 0.f;
#pragma unroll
    for (int j = 0; j < 4; ++j) {
      v[j] = *(const float4*)(xr + j * 256 + lane * 4);
      ss += v[j].x * v[j].x + v[j].y * v[j].y + v[j].z * v[j].z + v[j].w * v[j].w;
    }
    ss = wave_sum(ss);
    const float inv = rsqrtf(ss * (1.f / 1024.f) + 1e-6f);
#pragma unroll
    for (int j = 0; j < 4; ++j) {
      const int c0 = j * 256 + lane * 4;
      float4 g = *(const float4*)(nw + c0);
      float4 sh = *(const float4*)(mo + c0);
      float4 sc = *(const float4*)(mo + 1024 + c0);
      ushort4 o;
      o.x = f2bf(v[j].x * inv * g.x * (1.f + sc.x) + sh.x);
      o.y = f2bf(v[j].y * inv * g.y * (1.f + sc.y) + sh.y);
      o.z = f2bf(v[j].z * inv * g.z * (1.f + sc.z) + sh.z);
      o.w = f2bf(v[j].w * inv * g.w * (1.f + sc.w) + sh.w);
      *(ushort4*)(H + (size_t)t * 1024 + c0) = o;
    }
  }
}

__device__ void final_norm(const Params& p) {
  const int lane = TID() & 63;
  const int gw = BID() * 8 + (TID() >> 6), nw_ = gridDim.x * 8;
  for (int t = gw; t < TL; t += nw_) {
    float* xr = p.out + (size_t)t * 1024;
    float4 v[4];
    float ss = 0.f;
#pragma unroll
    for (int j = 0; j < 4; ++j) {
      v[j] = *(const float4*)(xr + j * 256 + lane * 4);
      ss += v[j].x * v[j].x + v[j].y * v[j].y + v[j].z * v[j].z + v[j].w * v[j].w;
    }
    ss = wave_sum(ss);
    const float inv = rsqrtf(ss * (1.f / 1024.f) + 1e-6f);
#pragma unroll
    for (int j = 0; j < 4; ++j) {
      const int c0 = j * 256 + lane * 4;
      float4 g = *(const float4*)(p.norm_f + c0);
      float4 o;
      o.x = v[j].x * inv * g.x; o.y = v[j].y * inv * g.y; o.z = v[j].z * inv * g.z; o.w = v[j].w * inv * g.w;
      *(float4*)(xr + c0) = o;
    }
  }
}

__device__ void prep3a_phase(const Params& p, int l) {
  const f16* RW = (const f16*)(WS(p) + OFF_RW);
  f16* Rb = (f16*)(WS(p) + OFF_R);
  f16* Kb = (f16*)(WS(p) + OFF_K);
  f16* Vb = (f16*)(WS(p) + OFF_V);
  u16* LORA = (u16*)(WS(p) + OFF_LORA);
  u16* GDS = (u16*)(WS(p) + OFF_GDS);
  float* INVN = (float*)(WS(p) + OFF_INVN);
  const float* mu = p.mu_shift + (size_t)l * 1920;
  const float* kk_w = p.k_k + (size_t)l * 512;
  const int lane = TID() & 63;
  const int gw = BID() * 8 + (TID() >> 6), nw_ = gridDim.x * 8;
  for (int t = gw; t < TA; t += nw_) {
    const bool lat = t < TL;
    int pos, row = 0, colg = 0;
    if (lat) { pos = t & 2047; row = pos >> 6; colg = pos & 63; } else { pos = (t - TL) & 255; }
#pragma unroll
    for (int it = 0; it < 4; ++it) {
      const int chunk = it * 64 + lane;
      if (chunk < 240) {
        const int c0 = chunk * 8;
        int nb = -1;
        if (lat) {
          const int q = c0 / 480;
          if (q == 0) { if (colg > 0) nb = t - 1; }
          else if (q == 1) { if (colg < 63) nb = t + 1; }
          else if (q == 2) { if (row > 0) nb = t - 64; }
          else { if (row < 31) nb = t + 64; }
        } else {
          if (c0 < 960) { if (pos > 0) nb = t - 1; }
          else { if (pos < 255) nb = t + 1; }
        }
        f16x8 raw = *(const f16x8*)(RW + (size_t)t * 1920 + c0);
        f16x8 nbv;
        if (nb >= 0) nbv = *(const f16x8*)(RW + (size_t)nb * 1920 + c0);
        else {
#pragma unroll
          for (int j = 0; j < 8; ++j) nbv[j] = (f16)0.f;
        }
        float4 m0 = *(const float4*)(mu + c0), m1 = *(const float4*)(mu + c0 + 4);
        float mm[8] = {m0.x, m0.y, m0.z, m0.w, m1.x, m1.y, m1.z, m1.w};
        float s[8];
#pragma unroll
        for (int j = 0; j < 8; ++j) {
          float a = (float)raw[j], b = (float)nbv[j];
          s[j] = a + mm[j] * (b - a);
        }
        if (it < 3) {
          f16x8 o;
#pragma unroll
          for (int j = 0; j < 8; ++j) o[j] = f2h(s[j]);
          f16* dst = (it == 0) ? Rb : ((it == 1) ? Kb : Vb);
          *(f16x8*)(dst + (size_t)t * 512 + (c0 - it * 512)) = o;
          if (it == 1) {
            const int cc = c0 - 512;
            float4 k0 = *(const float4*)(kk_w + cc), k1 = *(const float4*)(kk_w + cc + 4);
            float kw[8] = {k0.x, k0.y, k0.z, k0.w, k1.x, k1.y, k1.z, k1.w};
            float ss = 0.f;
#pragma unroll
            for (int j = 0; j < 8; ++j) { float q = (float)o[j] * kw[j]; ss += q * q; }
            ss = red8(ss);
            if ((lane & 7) == 0) INVN[(size_t)t * 8 + (lane >> 3)] = 1.f / fmaxf(sqrtf(ss), 1e-12f);
          }
        } else if (c0 < 1792) {
          u16x8 o;
          const bool th = c0 < 1664;
#pragma unroll
          for (int j = 0; j < 8; ++j) o[j] = f2bf(th ? tanhf(s[j]) : s[j]);
          *(u16x8*)(LORA + (size_t)t * 256 + (c0 - 1536)) = o;
        } else {
          u16x8 o;
#pragma unroll
          for (int j = 0; j < 8; ++j) o[j] = f2bf(sigmoidf_(s[j]));
          *(u16x8*)(GDS + (size_t)t * 128 + (c0 - 1792)) = o;
        }
      }
    }
  }
}

__device__ void post5a_phase(const Params& p, int l, int ntok) {
  const f16* Rb = (const f16*)(WS(p) + OFF_R);
  const f16* Kb = (const f16*)(WS(p) + OFF_K);
  const f16* Vb = (const f16*)(WS(p) + OFF_V);
  const f16* A0 = (const f16*)(WS(p) + OFF_AR);
  const f16* A1 = A0 + (size_t)TA * 512;
  f16* Y0 = (f16*)(WS(p) + OFF_YS0);
  const f16* Y1 = (const f16*)(WS(p) + OFF_YS1);
  const int lane = TID() & 63;
  const int c0 = lane * 8;
  float ka[8], rk[8], lw[8], lb[8];
#pragma unroll
  for (int j = 0; j < 8; ++j) {
    ka[j] = p.k_a[l * 512 + c0 + j];
    rk[j] = p.r_k[l * 512 + c0 + j];
    lw[j] = p.ln_x_w[l * 512 + c0 + j];
    lb[j] = p.ln_x_b[l * 512 + c0 + j];
  }
  const int gw = BID() * 8 + (TID() >> 6), nw_ = gridDim.x * 8;
  for (int t = gw; t < ntok; t += nw_) {
    const size_t o = (size_t)t * 512 + c0;
    f16x8 r = *(const f16x8*)(Rb + o), k = *(const f16x8*)(Kb + o), v = *(const f16x8*)(Vb + o);
    f16x8 a0 = *(const f16x8*)(A0 + o), a1 = *(const f16x8*)(A1 + o);
    f16x8 y0 = *(const f16x8*)(Y0 + o), y1 = *(const f16x8*)(Y1 + o);
    float y[8], bs = 0.f, sum = 0.f;
#pragma unroll
    for (int j = 0; j < 8; ++j) {
      float kf = (float)k[j];
      float kd0 = kf * (1.f + ((float)a0[j] - 1.f) * ka[j]);
      float kd1 = kf * (1.f + ((float)a1[j] - 1.f) * ka[j]);
      bs += (float)r[j] * (kd0 + kd1) * rk[j];
      y[j] = (float)y0[j] + (float)y1[j];
      sum += y[j];
    }
    bs = red8(bs);
    sum = red8(sum);
    const float mean = sum * (1.f / 64.f);
    float vs = 0.f;
#pragma unroll
    for (int j = 0; j < 8; ++j) { float d = y[j] - mean; vs += d * d; }
    vs = red8(vs);
    const float rstd = rsqrtf(vs * (1.f / 64.f) + 64e-5f);
    u16x8 z;
#pragma unroll
    for (int j = 0; j < 8; ++j) {
      float yn = (y[j] - mean) * rstd * lw[j] + lb[j];
      z[j] = f2bf(yn + bs * (float)v[j]);
    }
    *(u16x8*)((u16*)Y0 + o) = z;
  }
}

constexpr int TB = 32;
constexpr int NBLK = 2304 / TB;
constexpr int ST_VEC = TB * 320;
constexpr int ST_FLOATS = ST_VEC + TB * 32 * 2;

__device__ __forceinline__ int scan_token(int d, int b, int s) {
  if (s < 256) return TL + b * 256 + (d == 0 ? s : 255 - s);
  const int s2 = s - 256;
  return b * 2048 + (d == 0 ? s2 : 2047 - s2);
}

__device__ void scan_phase(const Params& p, int l, char* lds) {
  float* st = (float*)lds;
  const f16* Rb = (const f16*)(WS(p) + OFF_R);
  const f16* Kb = (const f16*)(WS(p) + OFF_K);
  const f16* Vb = (const f16*)(WS(p) + OFF_V);
  const float* INVN = (const float*)(WS(p) + OFF_INVN);
  const int tid = TID();
  for (int item = BID(); item < 256; item += gridDim.x) {
    const int chain = item >> 1, half = item & 1;
    const int d = chain >> 6, b = (chain >> 3) & 7, h = chain & 7;
    const f16* Eb = (const f16*)(WS(p) + OFF_EH) + (size_t)d * TA * 512;
    const f16* Ab = (const f16*)(WS(p) + OFF_AR) + (size_t)d * TA * 512;
    f16* Yb = (f16*)(WS(p) + (d == 0 ? OFF_YS0 : OFF_YS1));
    __syncthreads();
    if (__builtin_amdgcn_readfirstlane(tid >> 6) >= 4) {
      const int lt = tid - 256;
      const int step = lt >> 3, kp = lt & 7;
      const int cb = h * 64 + kp * 8;
      float kkw[8], kaw[8];
#pragma unroll
      for (int j = 0; j < 8; ++j) { kkw[j] = p.k_k[l * 512 + cb + j]; kaw[j] = p.k_a[l * 512 + cb + j]; }
      const int vcol = h * 64 + half * 32 + kp * 4;
      auto load_block = [&](int blk) {
        float* sg = st + (blk & 1) * ST_FLOATS;
        const int tok = scan_token(d, b, blk * TB + step);
        const size_t o = (size_t)tok * 512 + cb;
        f16x8 kv = *(const f16x8*)(Kb + o), rv = *(const f16x8*)(Rb + o);
        f16x8 ev = *(const f16x8*)(Eb + o), av = *(const f16x8*)(Ab + o);
        f16x4 vv = *(const f16x4*)(Vb + (size_t)tok * 512 + vcol);
        const float invn = INVN[(size_t)tok * 8 + h];
        float w[8], kk[8], ab[8], kd[8], rr[8];
#pragma unroll
        for (int j = 0; j < 8; ++j) {
          float kf = (float)kv[j], af = (float)av[j];
          w[j] = __expf(-(float)ev[j]);
          kk[j] = kf * kkw[j] * invn;
          ab[j] = kk[j] * af;
          kd[j] = kf * (1.f + (af - 1.f) * kaw[j]);
          rr[j] = (float)rv[j];
        }
        float* base = sg + step * 320 + kp * 8;
        *(float4*)(base + 0) = float4{w[0], w[1], w[2], w[3]};
        *(float4*)(base + 4) = float4{w[4], w[5], w[6], w[7]};
        *(float4*)(base + 64) = float4{kk[0], kk[1], kk[2], kk[3]};
        *(float4*)(base + 68) = float4{kk[4], kk[5], kk[6], kk[7]};
        *(float4*)(base + 128) = float4{ab[0], ab[1], ab[2], ab[3]};
        *(float4*)(base + 132) = float4{ab[4], ab[5], ab[6], ab[7]};
        *(float4*)(base + 192) = float4{kd[0], kd[1], kd[2], kd[3]};
        *(float4*)(base + 196) = float4{kd[4], kd[5], kd[6], kd[7]};
        *(float4*)(base + 256) = float4{rr[0], rr[1], rr[2], rr[3]};
        *(float4*)(base + 260) = float4{rr[4], rr[5], rr[6], rr[7]};
        *(float4*)(sg + ST_VEC + step * 32 + kp * 4) = float4{(float)vv[0], (float)vv[1], (float)vv[2], (float)vv[3]};
      };
      auto store_y = [&](int blk) {
        const float* sg = st + (blk & 1) * ST_FLOATS;
        const int tok = scan_token(d, b, blk * TB + step);
        float4 yv = *(const float4*)(sg + ST_VEC + TB * 32 + step * 32 + kp * 4);
        f16x4 o;
        o[0] = f2h(yv.x); o[1] = f2h(yv.y); o[2] = f2h(yv.z); o[3] = f2h(yv.w);
        *(f16x4*)(Yb + (size_t)tok * 512 + vcol) = o;
      };
      load_block(0);
      __syncthreads();
      for (int blk = 0; blk < NBLK; ++blk) {
        if (blk + 1 < NBLK) load_block(blk + 1);
        if (blk > 0) store_y(blk - 1);
        __syncthreads();
      }
      store_y(NBLK - 1);
    } else {
      const int lane = tid & 63, wave = tid >> 6;
      const int rl = wave * 8 + (lane >> 3), kp = lane & 7;
      float S[8];
#pragma unroll
      for (int j = 0; j < 8; ++j) S[j] = 0.f;
      __syncthreads();
      for (int blk = 0; blk < NBLK; ++blk) {
        float* sg = st + (blk & 1) * ST_FLOATS;
        const float* vb = sg + ST_VEC;
        float* yb = sg + ST_VEC + TB * 32;
#pragma unroll 2
        for (int t = 0; t < TB; ++t) {
          const float* base = sg + t * 320 + kp * 8;
          float4 w0 = *(const float4*)(base + 0), w1 = *(const float4*)(base + 4);
          float4 q0 = *(const float4*)(base + 64), q1 = *(const float4*)(base + 68);
          float4 a0 = *(const float4*)(base + 128), a1 = *(const float4*)(base + 132);
          float4 d0 = *(const float4*)(base + 192), d1 = *(const float4*)(base + 196);
          float4 r0 = *(const float4*)(base + 256), r1 = *(const float4*)(base + 260);
          const float vv = vb[t * 32 + rl];
          float sa0 = S[0] * q0.x + S[2] * q0.z;
          float sa1 = S[1] * q0.y + S[3] * q0.w;
          sa0 += S[4] * q1.x + S[6] * q1.z;
          sa1 += S[5] * q1.y + S[7] * q1.w;
          float sa = red8(sa0 + sa1);
          S[0] = (S[0] * w0.x + vv * d0.x) - sa * a0.x;
          S[1] = (S[1] * w0.y + vv * d0.y) - sa * a0.y;
          S[2] = (S[2] * w0.z + vv * d0.z) - sa * a0.z;
          S[3] = (S[3] * w0.w + vv * d0.w) - sa * a0.w;
          S[4] = (S[4] * w1.x + vv * d1.x) - sa * a1.x;
          S[5] = (S[5] * w1.y + vv * d1.y) - sa * a1.y;
          S[6] = (S[6] * w1.z + vv * d1.z) - sa * a1.z;
          S[7] = (S[7] * w1.w + vv * d1.w) - sa * a1.w;
          float y0 = S[0] * r0.x + S[2] * r0.z + S[4] * r1.x + S[6] * r1.z;
          float y1 = S[1] * r0.y + S[3] * r0.w + S[5] * r1.y + S[7] * r1.w;
          float y = red8(y0 + y1);
          if (kp == 0) yb[t * 32 + rl] = y;
        }
        __syncthreads();
      }
    }
  }
}

__device__ void proj_phase(const Params& p, char* lds) {
  const u16* H = (const u16*)(WS(p) + OFF_EH);
  const u16* WinT = (const u16*)(WS(p) + OFF_WTA + WO_IN);
  u16* FIN = (u16*)(WS(p) + OFF_FIN);
  f16* RW = (f16*)(WS(p) + OFF_RW);
  constexpr int MT = TA / 256, NT = 19;
  for (int tile = BID(); tile < MT * NT; tile += gridDim.x) {
    const int mt = tile / NT, nt = tile % NT;
    f32x4 acc[4][4];
    acc_zero(acc);
    gemm_loop(acc, H + (size_t)mt * 256 * 1024, 1024, WinT + (size_t)nt * 128 * 1024, 1024, 1024, lds);
    const int m0 = mt * 256, n0 = nt * 128;
    if (n0 < 512) {
      epi_apply(acc, lds, [&](int r, int c, float (&v)[8]) { *(u16x8*)(FIN + (size_t)(m0 + r) * 512 + n0 + c) = pack_bf8(v); });
    } else {
      epi_apply(acc, lds, [&](int r, int c, float (&v)[8]) { *(f16x8*)(RW + (size_t)(m0 + r) * 1920 + (n0 - 512) + c) = pack_h8(v); });
    }
  }
}

__device__ void dft1_phase(const Params& p, int l, char* lds) {
  const u16* FIN = (const u16*)(WS(p) + OFF_FIN);
  const u16* TW = (const u16*)(WS(p) + OFF_AR) + DM_TW;
  u16* UCS = (u16*)(WS(p) + OFF_EH);
  u16* UCSC = UCS + (size_t)32 * 256 * 2048;
  const int ntiles = 512 + (l == 0 ? 64 : 0);
  for (int tile = BID(); tile < ntiles; tile += gridDim.x) {
    const u16* bt;
    u16* o;
    int ldo;
    if (tile < 512) {
      const int bg = tile >> 4, nt = tile & 15, b = bg >> 2, g = bg & 3;
      bt = FIN + (size_t)(b * 2048 + nt * 128) * 512 + g * 128;
      o = UCS + (size_t)bg * 256 * 2048 + nt * 128;
      ldo = 2048;
    } else {
      const int t2 = tile - 512;
      const int bg = t2 >> 1, nt = t2 & 1, b = bg >> 2, g = bg & 3;
      bt = FIN + (size_t)(TL + b * 256 + nt * 128) * 512 + g * 128;
      o = UCSC + (size_t)bg * 256 * 256 + nt * 128;
      ldo = 256;
    }
    f32x4 acc[4][4];
    acc_zero(acc);
    gemm_loop(acc, TW, 128, bt, 512, 128, lds);
    epi_apply(acc, lds, [&](int r, int c, float (&v)[8]) { *(u16x8*)(o + (size_t)r * ldo + c) = pack_bf8(v); });
  }
}

__device__ void dft2_phase(const Params& p, int l, char* lds) {
  const u16* DM = (const u16*)(WS(p) + OFF_AR);
  const u16* UCS = (const u16*)(WS(p) + OFF_EH);
  const u16* UCSC = UCS + (size_t)32 * 256 * 2048;
  u16* FOUT = (u16*)(WS(p) + OFF_FIN);
  const int ntiles = 256 + (l == 0 ? 32 : 0);
  for (int tile = BID(); tile < ntiles; tile += gridDim.x) {
    const u16 *a0, *a1, *bt;
    u16* o;
    int Ld;
    float sc;
    if (tile < 256) {
      const int b = tile >> 5, mt = (tile >> 2) & 7, g = tile & 3;
      Ld = 2048;
      bt = UCS + (size_t)((b * 4 + g) * 256) * 2048;
      a0 = DM + DM_C + (size_t)mt * 256 * 2048;
      a1 = DM + DM_NS + (size_t)mt * 256 * 2048;
      o = FOUT + (size_t)(b * 2048 + mt * 256) * 512 + g * 128;
      sc = 1.f / 512.f;
    } else {
      const int t2 = tile - 256;
      const int b = t2 >> 2, g = t2 & 3;
      Ld = 256;
      bt = UCSC + (size_t)((b * 4 + g) * 256) * 256;
      a0 = DM + DM_CC;
      a1 = DM + DM_NSC;
      o = FOUT + (size_t)(TL + b * 256) * 512 + g * 128;
      sc = 0.005524271728019903f;
    }
    f32x4 acc[4][4];
    acc_zero(acc);
#pragma unroll 1
    for (int seg = 0; seg < 2; ++seg)
      gemm_loop(acc, seg == 0 ? a0 : a1, Ld, bt + (size_t)seg * 128 * Ld, Ld, Ld, lds);
    epi_apply(acc, lds, [&](int r, int c, float (&v)[8]) {
#pragma unroll
      for (int j = 0; j < 8; ++j) v[j] *= sc;
      *(u16x8*)(o + (size_t)r * 512 + c) = pack_bf8(v);
    });
  }
}

__device__ void lora_phase(const Params& p, int l, char* lds) {
  const u16* LORA = (const u16*)(WS(p) + OFF_LORA);
  const u16* WupT = (const u16*)(WS(p) + OFF_WTA + WO_WUP);
  const u16* AupT = (const u16*)(WS(p) + OFF_WTA + WO_AUP);
  constexpr int MT = TA / 256;
  for (int tile = BID(); tile < 4 * MT * 4; tile += gridDim.x) {
    const int which = tile / (MT * 4), rem = tile % (MT * 4), mt = rem >> 2, nt = rem & 3;
    const int d = which & 1;
    f32x4 acc[4][4];
    acc_zero(acc);
    const u16* bt = (which < 2 ? WupT : AupT) + (size_t)d * 512 * 64 + (size_t)nt * 128 * 64;
    gemm_loop(acc, LORA + (size_t)mt * 256 * 256 + which * 64, 256, bt, 64, 64, lds);
    f16* o = (f16*)(WS(p) + (which < 2 ? OFF_EH : OFF_AR)) + (size_t)d * TA * 512 + (size_t)mt * 256 * 512 + nt * 128;
    const float* bias = (which < 2 ? p.w0 : p.a0) + (size_t)l * 1024 + d * 512 + nt * 128;
    const float mul = (which < 2) ? 0.6065306597126334f : 1.f;
    epi_apply(acc, lds, [&](int r, int c, float (&v)[8]) {
      const float4 b0 = *(const float4*)(bias + c), b1 = *(const float4*)(bias + c + 4);
      const float bb[8] = {b0.x, b0.y, b0.z, b0.w, b1.x, b1.y, b1.z, b1.w};
#pragma unroll
      for (int j = 0; j < 8; ++j) v[j] = sigmoidf_(bb[j] + v[j]) * mul;
      *(f16x8*)(o + (size_t)r * 512 + c) = pack_h8(v);
    });
  }
}

__device__ void g_phase(const Params& p, int ntok, char* lds) {
  const u16* GDS = (const u16*)(WS(p) + OFF_GDS);
  const u16* GupT = (const u16*)(WS(p) + OFF_WTA + WO_GUP);
  u16* Z = (u16*)(WS(p) + OFF_YS0);
  const int MT = ntok / 256;
  for (int tile = BID(); tile < MT * 4; tile += gridDim.x) {
    const int mt = tile >> 2, nt = tile & 3;
    f32x4 acc[4][4];
    acc_zero(acc);
    gemm_loop(acc, GDS + (size_t)mt * 256 * 128, 128, GupT + (size_t)nt * 128 * 128, 128, 128, lds);
    u16* o = Z + (size_t)mt * 256 * 512 + nt * 128;
    epi_apply(acc, lds, [&](int r, int c, float (&v)[8]) {
      u16x8* q = (u16x8*)(o + (size_t)r * 512 + c);
      const u16x8 z = *q;
#pragma unroll
      for (int j = 0; j < 8; ++j) v[j] *= bf2f(z[j]);
      *q = pack_bf8(v);
    });
  }
}

__device__ void merge_phase(const Params& p, int ntok, char* lds) {
  const u16* H = (const u16*)(WS(p) + OFF_EH);
  const u16* WinT = (const u16*)(WS(p) + OFF_WTA + WO_IN);
  const u16* FOUT = (const u16*)(WS(p) + OFF_FIN);
  const u16* Z = (const u16*)(WS(p) + OFF_YS0);
  const u16* WfuT = (const u16*)(WS(p) + OFF_WTA + WO_FU);
  const u16* WruT = (const u16*)(WS(p) + OFF_WTA + WO_RU);
  u16* MG = (u16*)(WS(p) + OFF_AR);
  u16* SG = (u16*)(WS(p) + OFF_YS1);
  const int MT = ntok / 256;
  for (int tile = BID(); tile < MT * 8; tile += gridDim.x) {
    const int mt = tile >> 3, nt = tile & 7;
    u16* o = MG + (size_t)mt * 256 * 1024 + nt * 128;
    u16* sg = SG + (size_t)mt * 256 * 1024 + nt * 128;
#pragma unroll 1
    for (int sub = 0; sub < 4; ++sub) {
      const int pass = sub >> 1;
      const bool gate = (sub & 1) == 0;
      const u16* A = gate ? (H + (size_t)mt * 256 * 1024) : ((pass == 0 ? FOUT : Z) + (size_t)mt * 256 * 512);
      const u16* Bt = gate ? (WinT + (size_t)(2432 + pass * 1024 + nt * 128) * 1024)
                           : ((pass == 0 ? WfuT : WruT) + (size_t)nt * 128 * 512);
      const int K = gate ? 1024 : 512;
      f32x4 acc[4][4];
      acc_zero(acc);
      gemm_loop(acc, A, K, Bt, K, K, lds);
      epi_apply(acc, lds, [&](int r, int c, float (&v)[8]) {
        u16x8* qs = (u16x8*)(sg + (size_t)r * 1024 + c);
        u16x8* qo = (u16x8*)(o + (size_t)r * 1024 + c);
        if (gate) {
#pragma unroll
          for (int j = 0; j < 8; ++j) v[j] = sigmoidf_(v[j]);
          *qs = pack_bf8(v);
        } else {
          const u16x8 sv = *qs;
#pragma unroll
          for (int j = 0; j < 8; ++j) v[j] *= bf2f(sv[j]);
          if (pass == 1) {
            const u16x8 ov = *qo;
#pragma unroll
            for (int j = 0; j < 8; ++j) v[j] += bf2f(ov[j]);
          }
          *qo = pack_bf8(v);
        }
      });
    }
  }
}

__device__ void resid_gemm_phase(const Params& p, int l, int ntok, const u16* A, int K, const u16* Bt, int gate_off, char* lds) {
  const float* MOD = (const float*)(WS(p) + OFF_MOD);
  float* XC = (float*)(WS(p) + OFF_XC);
  const int MT = ntok / 256;
  for (int tile = BID(); tile < MT * 8; tile += gridDim.x) {
    const int mt = tile >> 3, nt = tile & 7;
    f32x4 acc[4][4];
    acc_zero(acc);
    gemm_loop(acc, A + (size_t)mt * 256 * K, K, Bt + (size_t)nt * 128 * K, K, K, lds);
    const int m0 = mt * 256, n0 = nt * 128;
    epi_apply(acc, lds, [&](int r, int c, float (&v)[8]) {
      const int row = m0 + r, col = n0 + c;
      float* q = (row < TL) ? (p.out + (size_t)row * 1024 + col) : (XC + (size_t)(row - TL) * 1024 + col);
      const float* gp = MOD + ((size_t)l * 9 + ((row < TL) ? (row >> 11) : 8)) * 6144 + gate_off + col;
      const float4 g0 = *(const float4*)gp, g1 = *(const float4*)(gp + 4);
      float4 x0 = *(const float4*)q, x1 = *(const float4*)(q + 4);
      x0.x += g0.x * v[0]; x0.y += g0.y * v[1]; x0.z += g0.z * v[2]; x0.w += g0.w * v[3];
      x1.x += g1.x * v[4]; x1.y += g1.y * v[5]; x1.z += g1.z * v[6]; x1.w += g1.w * v[7];
      *(float4*)q = x0; *(float4*)(q + 4) = x1;
    });
  }
}

__device__ void mlp_up_phase(const Params& p, int ntok, char* lds) {
  const u16* H2 = (const u16*)(WS(p) + OFF_EH);
  const u16* W1T = (const u16*)(WS(p) + OFF_W1T);
  u16* HID = (u16*)(WS(p) + OFF_HID);
  const int MT = ntok / 256;
  for (int tile = BID(); tile < MT * 32; tile += gridDim.x) {
    const int mt = tile >> 5, nt = tile & 31;
    f32x4 acc[4][4];
    acc_zero(acc);
    gemm_loop(acc, H2 + (size_t)mt * 256 * 1024, 1024, W1T + (size_t)nt * 128 * 1024, 1024, 1024, lds);
    u16* o = HID + (size_t)mt * 256 * 4096 + nt * 128;
    epi_apply(acc, lds, [&](int r, int c, float (&v)[8]) {
#pragma unroll
      for (int j = 0; j < 8; ++j) { const float t = fmaxf(v[j], 0.f); v[j] = t * t; }
      *(u16x8*)(o + (size_t)r * 4096 + c) = pack_bf8(v);
    });
  }
}

constexpr int PH_PER_LAYER = 13;
constexpr int N_PHASES = 1 + 2 * PH_PER_LAYER + 1;

__device__ void run_phase(const Params& p, int ph, char* lds) {
  if (ph == 0) {
    copy_f4(p.x, p.out, (size_t)TL * 1024 / 4);
    copy_f4(p.ctx, (float*)(WS(p) + OFF_XC), (size_t)TC * 1024 / 4);
    mod_phase(p, lds);
    return;
  }
  if (ph == N_PHASES - 1) { final_norm(p); return; }
  const int l = (ph - 1) / PH_PER_LAYER, q = (ph - 1) % PH_PER_LAYER;
  const int ntok = (l == 0) ? TA : TL;
  switch (q) {
    case 0:
      conv_phase(p, l, 0, lds);
      dftm_gen(p);
      normmod_phase(p, l, 0, TA, (u16*)(WS(p) + OFF_EH));
      break;
    case 1: proj_phase(p, lds); break;
    case 2: dft1_phase(p, l, lds); prep3a_phase(p, l); break;
    case 3: dft2_phase(p, l, lds); break;
    case 4: lora_phase(p, l, lds); break;
    case 5: scan_phase(p, l, lds); break;
    case 6:
      post5a_phase(p, l, ntok);
      normmod_phase(p, l, 0, ntok, (u16*)(WS(p) + OFF_EH));
      conv_phase(p, l, 1, lds);
      break;
    case 7: g_phase(p, ntok, lds); break;
    case 8: merge_phase(p, ntok, lds); break;
    case 9: resid_gemm_phase(p, l, ntok, (const u16*)(WS(p) + OFF_AR), 1024, (const u16*)(WS(p) + OFF_WTA + WO_OUT), 2048, lds); break;
    case 10: normmod_phase(p, l, 1, ntok, (u16*)(WS(p) + OFF_EH)); break;
    case 11: mlp_up_phase(p, ntok, lds); break;
    case 12: resid_gemm_phase(p, l, ntok, (const u16*)(WS(p) + OFF_HID), 4096, (const u16*)(WS(p) + OFF_W2T), 5120, lds); break;
  }
}

extern "C" __global__ void __launch_bounds__(NTHREADS) fwd_megakernel(Params p) {
  extern __shared__ __attribute__((aligned(16))) char lds[];
#if ONE_LAUNCH
  cg::grid_group grid = cg::this_grid();
  for (int ph = p.ph_lo; ph < p.ph_hi; ++ph) {
    run_phase(p, ph, lds);
    if (ph + 1 < p.ph_hi) grid.sync();
  }
#else
  for (int ph = p.ph_lo; ph < p.ph_hi; ++ph) run_phase(p, ph, lds);
#endif
}

extern "C" void kernel_launch(void* const* d_in, const int* in_sizes, int n_in, void* d_out, int out_size, void* d_ws,
                              size_t ws_size, hipStream_t stream) {
  static int grid = 0;
  if (grid == 0) {
    if (ws_size < WS_NEED) { fprintf(stderr, "kernel_launch: workspace too small: %zu < %zu\n", ws_size, (size_t)WS_NEED); grid = -1; return; }
    int dev = 0, cus = 0, per_cu = 0;
    hipGetDevice(&dev);
    hipDeviceGetAttribute(&cus, hipDeviceAttributeMultiprocessorCount, dev);
    hipFuncSetAttribute((const void*)fwd_megakernel, hipFuncAttributeMaxDynamicSharedMemorySize, LDS_BYTES);
    hipOccupancyMaxActiveBlocksPerMultiprocessor(&per_cu, (const void*)fwd_megakernel, NTHREADS, LDS_BYTES);
    if (per_cu < 1) per_cu = 1;
    grid = cus;
    (void)hipGetLastError();
  }
  if (grid < 0) return;
  Params p{};
  const float** pp = (const float**)&p;
  for (int i = 0; i < 26; ++i) pp[i] = (const float*)d_in[i];
  p.out = (float*)d_out;
  p.ws = (char*)d_ws;
#if ONE_LAUNCH
  p.ph_lo = 0; p.ph_hi = N_PHASES;
  void* args[] = {&p};
  hipError_t e = hipLaunchCooperativeKernel((const void*)fwd_megakernel, dim3(grid), dim3(NTHREADS), args, LDS_BYTES, stream);
  if (e != hipSuccess) fprintf(stderr, "cooperative launch failed: %s (grid %d)\n", hipGetErrorString(e), grid);
#else
  for (int ph = 0; ph < N_PHASES; ++ph) {
    p.ph_lo = ph; p.ph_hi = ph + 1;
    hipLaunchKernelGGL(fwd_megakernel, dim3(grid), dim3(NTHREADS), LDS_BYTES, stream, p);
  }
#endif
}
```

```cpp
#include <hip/hip_runtime.h>
#include <hip/hip_cooperative_groups.h>
#include <cstdio>
#include <cstdint>
#include <cstddef>
namespace cg = cooperative_groups;

typedef unsigned short u16;
typedef _Float16 f16;
using bf16x8 = __attribute__((ext_vector_type(8))) short;
using f32x4 = __attribute__((ext_vector_type(4))) float;
using f32x2 = __attribute__((ext_vector_type(2))) float;
using f16x8 = __attribute__((ext_vector_type(8))) _Float16;
using f16x4 = __attribute__((ext_vector_type(4))) _Float16;
using u16x8 = __attribute__((ext_vector_type(8))) unsigned short;

#ifndef ONE_LAUNCH
#define ONE_LAUNCH 1
#endif

constexpr int D = 1024, NB = 8, L = 2048, LC = 256, TL = 16384, TC = 2048, TA = 18432;
constexpr int NTHREADS = 512;
constexpr int LDT = 72;
constexpr int STAGE_ELEMS = (256 + 128) * LDT;
constexpr int LDS_BYTES = 2 * STAGE_ELEMS * 2;

constexpr size_t MiB = (size_t)1 << 20;
constexpr size_t OFF_MOD = 0;
constexpr size_t OFF_XC = 1 * MiB;
constexpr size_t OFF_WTA = 9 * MiB;
constexpr size_t OFF_FIN = 23 * MiB;
constexpr size_t OFF_EH = 41 * MiB;
constexpr size_t OFF_RW = 77 * MiB;
constexpr size_t OFF_W1T = 77 * MiB;
constexpr size_t OFF_W2T = 85 * MiB;
constexpr size_t OFF_YS0 = 93 * MiB;
constexpr size_t OFF_YS1 = 111 * MiB;
constexpr size_t OFF_HID = 93 * MiB;
constexpr size_t OFF_R = 144 * MiB + MiB / 2;
constexpr size_t OFF_K = OFF_R + 18 * MiB;
constexpr size_t OFF_V = OFF_K + 18 * MiB;
constexpr size_t OFF_AR = OFF_V + 18 * MiB;
constexpr size_t OFF_LORA = OFF_AR + 36 * MiB;
constexpr size_t OFF_GDS = OFF_LORA + 9 * MiB;
constexpr size_t OFF_INVN = OFF_GDS + 4 * MiB + MiB / 2;
constexpr size_t OFF_BAR = 250 * MiB;
constexpr size_t WS_NEED = OFF_BAR + MiB;
constexpr size_t WO_IN = 0, WO_FU = 9175040, WO_RU = 10223616, WO_OUT = 11272192, WO_WUP = 13369344, WO_AUP = 13500416, WO_GUP = 13631488;
constexpr size_t DM_C = 0, DM_NS = (size_t)2048 * 2048, DM_CC = (size_t)2 * 2048 * 2048, DM_NSC = DM_CC + 65536, DM_TW = DM_NSC + 65536;

struct Params {
  const float *x, *c, *ctx, *c_ctx, *w_mod, *b_mod, *norm1, *norm2, *w_in, *mu_shift, *w0, *w_up, *a0, *a_up, *g_up,
      *k_k, *k_a, *r_k, *ln_x_w, *ln_x_b, *w_fourier_up, *w_rwkv_up, *w_out, *mlp_w1, *mlp_w2, *norm_f;
  float* out;
  char* ws;
  int ph_lo, ph_hi;
};
__device__ __forceinline__ char* WS(const Params& p) { int z = 0; asm volatile("" : "+s"(z)); return p.ws + z; }


__device__ __forceinline__ int TID() { int t = threadIdx.x; asm volatile("" : "+v"(t)); return t; }
__device__ __forceinline__ int BID() { int t = blockIdx.x; asm volatile("" : "+s"(t)); return t; }
__device__ __forceinline__ u16 f2bf(float f) {
  uint32_t u = __float_as_uint(f);
  u += 0x7fffu + ((u >> 16) & 1u);
  return (u16)(u >> 16);
}
__device__ __forceinline__ float bf2f(u16 h) { return __uint_as_float(((uint32_t)h) << 16); }
__device__ __forceinline__ float sigmoidf_(float x) { return 1.f / (1.f + __expf(-x)); }
__device__ __forceinline__ f16 f2h(float v) { v = fminf(fmaxf(v, -60000.f), 60000.f); return (f16)v; }

template <int CTRL>
__device__ __forceinline__ float dpp_f(float x) {
  return __int_as_float(__builtin_amdgcn_update_dpp(0, __float_as_int(x), CTRL, 0xf, 0xf, true));
}
__device__ __forceinline__ float red8(float x) {
  x += dpp_f<0xB1>(x);
  x += dpp_f<0x4E>(x);
  x += dpp_f<0x141>(x);
  return x;
}
__device__ __forceinline__ float wave_sum(float v) {
#pragma unroll
  for (int o = 32; o > 0; o >>= 1) v += __shfl_xor(v, o, 64);
  return v;
}

__device__ __forceinline__ void gemm_loop(f32x4 (&acc)[4][4], const u16* __restrict__ A, int lda,
                                          const u16* __restrict__ Bt, int ldb, int K, char* lds) {
  const int tid = TID();
  const int lane = tid & 63, wave = tid >> 6;
  const int wm = wave >> 1, wn = wave & 1;
  u16* s0 = (u16*)lds;
  const int lr = tid >> 3, lc = (tid & 7) * 8;
  const u16* ap0 = A + (size_t)lr * lda + lc;
  const u16* ap1 = ap0 + (size_t)64 * lda;
  const u16* ap2 = ap0 + (size_t)128 * lda;
  const u16* ap3 = ap0 + (size_t)192 * lda;
  const u16* bp0 = Bt + (size_t)lr * ldb + lc;
  const u16* bp1 = bp0 + (size_t)64 * ldb;
  const int KT = K >> 6;
  const int wofa = lr * LDT + lc;
  const int wofb = 256 * LDT + wofa;
  __syncthreads();
  uint4 ra0 = *(const uint4*)ap0, ra1 = *(const uint4*)ap1, ra2 = *(const uint4*)ap2, ra3 = *(const uint4*)ap3;
  uint4 rb0 = *(const uint4*)bp0, rb1 = *(const uint4*)bp1;
  *(uint4*)(s0 + wofa) = ra0;
  *(uint4*)(s0 + wofa + 64 * LDT) = ra1;
  *(uint4*)(s0 + wofa + 128 * LDT) = ra2;
  *(uint4*)(s0 + wofa + 192 * LDT) = ra3;
  *(uint4*)(s0 + wofb) = rb0;
  *(uint4*)(s0 + wofb + 64 * LDT) = rb1;
  __syncthreads();
  const int arow = (wm * 64 + (lane & 15)) * LDT + (lane >> 4) * 8;
  const int brow = (wn * 64 + (lane & 15)) * LDT + (lane >> 4) * 8;
  for (int kt = 0; kt < KT; ++kt) {
    const int s = kt & 1;
    const bool more = (kt + 1 < KT);
    if (more) {
      const int ko = (kt + 1) * 64;
      ra0 = *(const uint4*)(ap0 + ko); ra1 = *(const uint4*)(ap1 + ko);
      ra2 = *(const uint4*)(ap2 + ko); ra3 = *(const uint4*)(ap3 + ko);
      rb0 = *(const uint4*)(bp0 + ko); rb1 = *(const uint4*)(bp1 + ko);
    }
    const u16* sa = s0 + s * STAGE_ELEMS;
    const u16* sb = sa + 256 * LDT;
#pragma unroll
    for (int ks = 0; ks < 2; ++ks) {
      const bf16x8 a0 = *(const bf16x8*)(sa + arow + ks * 32);
      const bf16x8 a1 = *(const bf16x8*)(sa + arow + 16 * LDT + ks * 32);
      const bf16x8 a2 = *(const bf16x8*)(sa + arow + 32 * LDT + ks * 32);
      const bf16x8 a3 = *(const bf16x8*)(sa + arow + 48 * LDT + ks * 32);
      const bf16x8 b0 = *(const bf16x8*)(sb + brow + ks * 32);
      const bf16x8 b1 = *(const bf16x8*)(sb + brow + 16 * LDT + ks * 32);
      const bf16x8 b2 = *(const bf16x8*)(sb + brow + 32 * LDT + ks * 32);
      const bf16x8 b3 = *(const bf16x8*)(sb + brow + 48 * LDT + ks * 32);
#define MF(i, j, av, bv) acc[i][j] = __builtin_amdgcn_mfma_f32_16x16x32_bf16(av, bv, acc[i][j], 0, 0, 0)
      MF(0, 0, a0, b0); MF(0, 1, a0, b1); MF(0, 2, a0, b2); MF(0, 3, a0, b3);
      MF(1, 0, a1, b0); MF(1, 1, a1, b1); MF(1, 2, a1, b2); MF(1, 3, a1, b3);
      MF(2, 0, a2, b0); MF(2, 1, a2, b1); MF(2, 2, a2, b2); MF(2, 3, a2, b3);
      MF(3, 0, a3, b0); MF(3, 1, a3, b1); MF(3, 2, a3, b2); MF(3, 3, a3, b3);
#undef MF
    }
    if (more) {
      u16* w = s0 + (s ^ 1) * STAGE_ELEMS;
      *(uint4*)(w + wofa) = ra0;
      *(uint4*)(w + wofa + 64 * LDT) = ra1;
      *(uint4*)(w + wofa + 128 * LDT) = ra2;
      *(uint4*)(w + wofa + 192 * LDT) = ra3;
      *(uint4*)(w + wofb) = rb0;
      *(uint4*)(w + wofb + 64 * LDT) = rb1;
    }
    __syncthreads();
  }
}

__device__ __forceinline__ void acc_zero(f32x4 (&acc)[4][4]) {
#pragma unroll
  for (int i = 0; i < 4; ++i)
#pragma unroll
    for (int j = 0; j < 4; ++j) acc[i][j] = f32x4{0.f, 0.f, 0.f, 0.f};
}

template <class F>
__device__ __forceinline__ void epi_apply(f32x4 (&acc)[4][4], char* lds, F f) {
  const int lane = TID() & 63, wave = TID() >> 6;
  const int wm = wave >> 1, wn = wave & 1;
  float* sw = (float*)lds + wave * (32 * 68);
#pragma unroll
  for (int hp = 0; hp < 2; ++hp) {
#pragma unroll
    for (int m2 = 0; m2 < 2; ++m2)
#pragma unroll
      for (int nf = 0; nf < 4; ++nf)
#pragma unroll
        for (int r = 0; r < 4; ++r)
          sw[(m2 * 16 + (lane >> 4) * 4 + r) * 68 + nf * 16 + (lane & 15)] = acc[hp * 2 + m2][nf][r];
    __builtin_amdgcn_wave_barrier();
#pragma unroll
    for (int i = 0; i < 4; ++i) {
      const int rr = i * 8 + (lane >> 3), cc = (lane & 7) * 8;
      const float4 a = *(const float4*)(sw + rr * 68 + cc), b = *(const float4*)(sw + rr * 68 + cc + 4);
      float v[8] = {a.x, a.y, a.z, a.w, b.x, b.y, b.z, b.w};
      f(wm * 64 + hp * 32 + rr, wn * 64 + cc, v);
    }
    __builtin_amdgcn_wave_barrier();
  }
}

__device__ __forceinline__ u16x8 pack_bf8(const float (&v)[8]) {
  u16x8 o;
#pragma unroll
  for (int j = 0; j < 8; ++j) o[j] = f2bf(v[j]);
  return o;
}
__device__ __forceinline__ f16x8 pack_h8(const float (&v)[8]) {
  f16x8 o;
#pragma unroll
  for (int j = 0; j < 8; ++j) o[j] = f2h(v[j]);
  return o;
}

__device__ void copy_f4(const float* __restrict__ src, float* __restrict__ dst, size_t n4) {
  const float4* s = (const float4*)src; float4* d = (float4*)dst;
  for (size_t i = (size_t)BID() * NTHREADS + TID(); i < n4; i += (size_t)gridDim.x * NTHREADS) d[i] = s[i];
}

__device__ void mod_phase(const Params& p, char* lds) {
  float* sl = (float*)lds;
  float* red = sl + 9 * 1024;
  float* MOD = (float*)(WS(p) + OFF_MOD);
  const int tid = TID(), lane = tid & 63, wave = tid >> 6;
  __syncthreads();
  for (int i = tid; i < 9 * 1024; i += NTHREADS) {
    float v = (i < 8 * 1024) ? p.c[i] : p.c_ctx[i - 8 * 1024];
    sl[i] = v * sigmoidf_(v);
  }
  __syncthreads();
  for (int item = BID(); item < 192; item += gridDim.x) {
    const int l = item / 96, n0 = (item % 96) * 64;
    const float* w = p.w_mod + (size_t)l * 1024 * 6144 + n0 + lane;
    float acc[9];
#pragma unroll
    for (int r = 0; r < 9; ++r) acc[r] = 0.f;
    const int kbeg = wave * 128;
#pragma unroll 8
    for (int k = kbeg; k < kbeg + 128; ++k) {
      float wv = w[(size_t)k * 6144];
#pragma unroll
      for (int r = 0; r < 9; ++r) acc[r] += sl[r * 1024 + k] * wv;
    }
#pragma unroll
    for (int r = 0; r < 9; ++r) red[(wave * 9 + r) * 64 + lane] = acc[r];
    __syncthreads();
    for (int i = tid; i < 9 * 64; i += NTHREADS) {
      int r = i >> 6, ln = i & 63;
      float s = 0.f;
#pragma unroll
      for (int w8 = 0; w8 < 8; ++w8) s += red[(w8 * 9 + r) * 64 + ln];
      MOD[((size_t)l * 9 + r) * 6144 + n0 + ln] = s + p.b_mod[(size_t)l * 6144 + n0 + ln];
    }
    __syncthreads();
  }
}

__device__ void convT_tile(const float* __restrict__ src, int K, int N, u16* __restrict__ dst, int t, char* lds) {
  float* tile = (float*)lds;
  const int tid = TID();
  const int nT = N >> 6;
  const int k0 = (t / nT) * 64, n0 = (t % nT) * 64;
  __syncthreads();
#pragma unroll
  for (int i = 0; i < 8; ++i) {
    int k = (tid >> 6) + 8 * i, n = tid & 63;
    tile[k * 65 + n] = src[(size_t)(k0 + k) * N + n0 + n];
  }
  __syncthreads();
  {
    int n = tid >> 3, kc = (tid & 7) * 8;
    u16x8 o;
#pragma unroll
    for (int j = 0; j < 8; ++j) o[j] = f2bf(tile[(kc + j) * 65 + n]);
    *(u16x8*)(dst + (size_t)(n0 + n) * K + k0 + kc) = o;
  }
}

__device__ void conv_phase(const Params& p, int l, int set, char* lds) {
  char* wta = WS(p) + OFF_WTA;
  const int total = (set == 0) ? 1680 : 2048;
  for (int t = BID(); t < total; t += gridDim.x) {
    int tt = t;
    const float* src; int K, N; u16* dst;
    if (set == 0) {
      if (tt < 1120) { src = p.w_in + (size_t)l * 1024 * 4480; K = 1024; N = 4480; dst = (u16*)(wta + WO_IN); }
      else if ((tt -= 1120) < 128) { src = p.w_fourier_up + (size_t)l * 512 * 1024; K = 512; N = 1024; dst = (u16*)(wta + WO_FU); }
      else if ((tt -= 128) < 128) { src = p.w_rwkv_up + (size_t)l * 512 * 1024; K = 512; N = 1024; dst = (u16*)(wta + WO_RU); }
      else if ((tt -= 128) < 256) { src = p.w_out + (size_t)l * 1024 * 1024; K = 1024; N = 1024; dst = (u16*)(wta + WO_OUT); }
      else if ((tt -= 256) < 16) { const int d = tt >> 3; tt &= 7; src = p.w_up + (size_t)(l * 2 + d) * 64 * 512; K = 64; N = 512; dst = (u16*)(wta + WO_WUP) + d * 512 * 64; }
      else if ((tt -= 16) < 16) { const int d = tt >> 3; tt &= 7; src = p.a_up + (size_t)(l * 2 + d) * 64 * 512; K = 64; N = 512; dst = (u16*)(wta + WO_AUP) + d * 512 * 64; }
      else { tt -= 16; src = p.g_up + (size_t)l * 128 * 512; K = 128; N = 512; dst = (u16*)(wta + WO_GUP); }
    } else {
      if (tt < 1024) { src = p.mlp_w1 + (size_t)l * 1024 * 4096; K = 1024; N = 4096; dst = (u16*)(WS(p) + OFF_W1T); }
      else { tt -= 1024; src = p.mlp_w2 + (size_t)l * 4096 * 1024; K = 4096; N = 1024; dst = (u16*)(WS(p) + OFF_W2T); }
    }
    convT_tile(src, K, N, dst, tt, lds);
  }
}

__device__ void dftm_gen(const Params& p) {
  u16* DM = (u16*)(WS(p) + OFF_AR);
  const size_t gt = (size_t)BID() * NTHREADS + TID(), gs = (size_t)gridDim.x * NTHREADS;
  const float TWO_PI = 6.283185307179586f;
  for (size_t i = gt; i < (size_t)2048 * 2048; i += gs) {
    int k = (int)(i >> 11), l = (int)(i & 2047);
    int m = (k * l) & 2047;
    float s, c;
    sincosf(TWO_PI * (float)m * (1.f / 2048.f), &s, &c);
    DM[DM_C + i] = f2bf(c);
    DM[DM_NS + i] = f2bf(-s);
  }
  for (size_t i = gt; i < (size_t)256 * 256; i += gs) {
    int k = (int)(i >> 8), l = (int)(i & 255);
    int m = (k * l) & 255;
    float s, c;
    sincosf(TWO_PI * (float)m * (1.f / 256.f), &s, &c);
    DM[DM_CC + i] = f2bf(c);
    DM[DM_NSC + i] = f2bf(-s);
  }
  for (size_t i = gt; i < (size_t)256 * 128; i += gs) {
    int row = (int)(i >> 7), cch = (int)(i & 127);
    int j = row & 127;
    int m = (j * cch) & 127;
    float s, c;
    sincosf(TWO_PI * (float)m * (1.f / 128.f), &s, &c);
    DM[DM_TW + i] = f2bf(row < 128 ? c : s);
  }
}

__device__ void normmod_phase(const Params& p, int l, int which, int ntok, u16* __restrict__ H) {
  const float* MOD = (const float*)(WS(p) + OFF_MOD);
  const float* XC = (const float*)(WS(p) + OFF_XC);
  const float* nw = (which == 0 ? p.norm1 : p.norm2) + l * 1024;
  const int lane = TID() & 63;
  const int gw = BID() * 8 + (TID() >> 6), nw_ = gridDim.x * 8;
  for (int t = gw; t < ntok; t += nw_) {
    const float* xr = (t < TL) ? (p.out + (size_t)t * 1024) : (XC + (size_t)(t - TL) * 1024);
    const int mrow = (t < TL) ? (t >> 11) : 8;
    const float* mo = MOD + ((size_t)l * 9 + mrow) * 6144 + which * 3072;
    float4 v[4];
    float ss = 0.f;
#pragma unroll
    for (int j = 0; j < 4; ++j) {
      v[j] = *(const float4*)(xr + j * 256 + lane * 4);
      ss += v[j].x * v[j].x + v[j].y * v[j].y + v[j].z * v[j].z + v[j].w * v[j].w;
    }
    ss = wave_sum(ss);
    const float inv = rsqrtf(ss * (1.f / 1024.f) + 1e-6f);
#pragma unroll
    for (int j = 0; j < 4; ++j) {
      const int c0 = j * 256 + lane * 4;
      float4 g = *(const float4*)(nw + c0);
      float4 sh = *(const float4*)(mo + c0);
      float4 sc = *(const float4*)(mo + 1024 + c0);
      ushort4 o;
      o.x = f2bf(v[j].x * inv * g.x * (1.f + sc.x) + sh.x);
      o.y = f2bf(v[j].y * inv * g.y * (1.f + sc.y) + sh.y);
      o.z = f2bf(v[j].z * inv * g.z * (1.f + sc.z) + sh.z);
      o.w = f2bf(v[j].w * inv * g.w * (1.f + sc.w) + sh.w);
      *(ushort4*)(H + (size_t)t * 1024 + c0) = o;
    }
  }
}

__device__ void final_norm(const Params& p) {
  const int lane = TID() & 63;
  const int gw = BID() * 8 + (TID() >> 6), nw_ = gridDim.x * 8;
  for (int t = gw; t < TL; t += nw_) {
    float* xr = p.out + (size_t)t * 1024;
    float4 v[4];
    float ss = 0.f;
#pragma unroll
    for (int j = 0; j < 4; ++j) {
      v[j] = *(const float4*)(xr + j * 256 + lane * 4);
      ss += v[j].x * v[j].x + v[j].y * v[j].y + v[j].z * v[j].z + v[j].w * v[j].w;
    }
    ss = wave_sum(ss);
    const float inv = rsqrtf(ss * (1.f / 1024.f) + 1e-6f);
#pragma unroll
    for (int j = 0; j < 4; ++j) {
      const int c0 = j * 256 + lane * 4;
      float4 g = *(const float4*)(p.norm_f + c0);
      float4 o;
      o.x = v[j].x * inv * g.x; o.y = v[j].y * inv * g.y; o.z = v[j].z * inv * g.z; o.w = v[j].w * inv * g.w;
      *(float4*)(xr + c0) = o;
    }
  }
}

__device__ void prep3a_phase(const Params& p, int l) {
  const f16* RW = (const f16*)(WS(p) + OFF_RW);
  f16* Rb = (f16*)(WS(p) + OFF_R);
  f16* Kb = (f16*)(WS(p) + OFF_K);
  f16* Vb = (f16*)(WS(p) + OFF_V);
  u16* LORA = (u16*)(WS(p) + OFF_LORA);
  u16* GDS = (u16*)(WS(p) + OFF_GDS);
  float* INVN = (float*)(WS(p) + OFF_INVN);
  const float* mu = p.mu_shift + (size_t)l * 1920;
  const float* kk_w = p.k_k + (size_t)l * 512;
  const int lane = TID() & 63;
  const int gw = BID() * 8 + (TID() >> 6), nw_ = gridDim.x * 8;
  for (int t = gw; t < TA; t += nw_) {
    const bool lat = t < TL;
    int pos, row = 0, colg = 0;
    if (lat) { pos = t & 2047; row = pos >> 6; colg = pos & 63; } else { pos = (t - TL) & 255; }
#pragma unroll
    for (int it = 0; it < 4; ++it) {
      const int chunk = it * 64 + lane;
      if (chunk < 240) {
        const int c0 = chunk * 8;
        int nb = -1;
        if (lat) {
          const int q = c0 / 480;
          if (q == 0) { if (colg > 0) nb = t - 1; }
          else if (q == 1) { if (colg < 63) nb = t + 1; }
          else if (q == 2) { if (row > 0) nb = t - 64; }
          else { if (row < 31) nb = t + 64; }
        } else {
          if (c0 < 960) { if (pos > 0) nb = t - 1; }
          else { if (pos < 255) nb = t + 1; }
        }
        f16x8 raw = *(const f16x8*)(RW + (size_t)t * 1920 + c0);
        f16x8 nbv;
        if (nb >= 0) nbv = *(const f16x8*)(RW + (size_t)nb * 1920 + c0);
        else {
#pragma unroll
          for (int j = 0; j < 8; ++j) nbv[j] = (f16)0.f;
        }
        float4 m0 = *(const float4*)(mu + c0), m1 = *(const float4*)(mu + c0 + 4);
        float mm[8] = {m0.x, m0.y, m0.z, m0.w, m1.x, m1.y, m1.z, m1.w};
        float s[8];
#pragma unroll
        for (int j = 0; j < 8; ++j) {
          float a = (float)raw[j], b = (float)nbv[j];
          s[j] = a + mm[j] * (b - a);
        }
        if (it < 3) {
          f16x8 o;
#pragma unroll
          for (int j = 0; j < 8; ++j) o[j] = f2h(s[j]);
          f16* dst = (it == 0) ? Rb : ((it == 1) ? Kb : Vb);
          *(f16x8*)(dst + (size_t)t * 512 + (c0 - it * 512)) = o;
          if (it == 1) {
            const int cc = c0 - 512;
            float4 k0 = *(const float4*)(kk_w + cc), k1 = *(const float4*)(kk_w + cc + 4);
            float kw[8] = {k0.x, k0.y, k0.z, k0.w, k1.x, k1.y, k1.z, k1.w};
            float ss = 0.f;
#pragma unroll
            for (int j = 0; j < 8; ++j) { float q = (float)o[j] * kw[j]; ss += q * q; }
            ss = red8(ss);
            if ((lane & 7) == 0) INVN[(size_t)t * 8 + (lane >> 3)] = 1.f / fmaxf(sqrtf(ss), 1e-12f);
          }
        } else if (c0 < 1792) {
          u16x8 o;
          const bool th = c0 < 1664;
#pragma unroll
          for (int j = 0; j < 8; ++j) o[j] = f2bf(th ? tanhf(s[j]) : s[j]);
          *(u16x8*)(LORA + (size_t)t * 256 + (c0 - 1536)) = o;
        } else {
          u16x8 o;
#pragma unroll
          for (int j = 0; j < 8; ++j) o[j] = f2bf(sigmoidf_(s[j]));
          *(u16x8*)(GDS + (size_t)t * 128 + (c0 - 1792)) = o;
        }
      }
    }
  }
}

__device__ void post5a_phase(const Params& p, int l, int ntok) {
  const f16* Rb = (const f16*)(WS(p) + OFF_R);
  const f16* Kb = (const f16*)(WS(p) + OFF_K);
  const f16* Vb = (const f16*)(WS(p) + OFF_V);
  const f16* A0 = (const f16*)(WS(p) + OFF_AR);
  const f16* A1 = A0 + (size_t)TA * 512;
  f16* Y0 = (f16*)(WS(p) + OFF_YS0);
  const f16* Y1 = (const f16*)(WS(p) + OFF_YS1);
  const int lane = TID() & 63;
  const int c0 = lane * 8;
  float ka[8], rk[8], lw[8], lb[8];
#pragma unroll
  for (int j = 0; j < 8; ++j) {
    ka[j] = p.k_a[l * 512 + c0 + j];
    rk[j] = p.r_k[l * 512 + c0 + j];
    lw[j] = p.ln_x_w[l * 512 + c0 + j];
    lb[j] = p.ln_x_b[l * 512 + c0 + j];
  }
  const int gw = BID() * 8 + (TID() >> 6), nw_ = gridDim.x * 8;
  for (int t = gw; t < ntok; t += nw_) {
    const size_t o = (size_t)t * 512 + c0;
    f16x8 r = *(const f16x8*)(Rb + o), k = *(const f16x8*)(Kb + o), v = *(const f16x8*)(Vb + o);
    f16x8 a0 = *(const f16x8*)(A0 + o), a1 = *(const f16x8*)(A1 + o);
    f16x8 y0 = *(const f16x8*)(Y0 + o), y1 = *(const f16x8*)(Y1 + o);
    float y[8], bs = 0.f, sum = 0.f;
#pragma unroll
    for (int j = 0; j < 8; ++j) {
      float kf = (float)k[j];
      float kd0 = kf * (1.f + ((float)a0[j] - 1.f) * ka[j]);
      float kd1 = kf * (1.f + ((float)a1[j] - 1.f) * ka[j]);
      bs += (float)r[j] * (kd0 + kd1) * rk[j];
      y[j] = (float)y0[j] + (float)y1[j];
      sum += y[j];
    }
    bs = red8(bs);
    sum = red8(sum);
    const float mean = sum * (1.f / 64.f);
    float vs = 0.f;
#pragma unroll
    for (int j = 0; j < 8; ++j) { float d = y[j] - mean; vs += d * d; }
    vs = red8(vs);
    const float rstd = rsqrtf(vs * (1.f / 64.f) + 64e-5f);
    u16x8 z;
#pragma unroll
    for (int j = 0; j < 8; ++j) {
      float yn = (y[j] - mean) * rstd * lw[j] + lb[j];
      z[j] = f2bf(yn + bs * (float)v[j]);
    }
    *(u16x8*)((u16*)Y0 + o) = z;
  }
}

constexpr int TB = 32;
constexpr int NBLK = 2304 / TB;
constexpr int ST_VEC = TB * 320;
constexpr int ST_FLOATS = ST_VEC + TB * 32 * 2;

__device__ __forceinline__ int scan_token(int d, int b, int s) {
  if (s < 256) return TL + b * 256 + (d == 0 ? s : 255 - s);
  const int s2 = s - 256;
  return b * 2048 + (d == 0 ? s2 : 2047 - s2);
}

__device__ __forceinline__ float red16(float x) {
  x += dpp_f<0xB1>(x);
  x += dpp_f<0x4E>(x);
  x += dpp_f<0x141>(x);
  x += dpp_f<0x140>(x);
  return x;
}

__device__ void scan_phase(const Params& p, int l, char* lds) {
  float* st = (float*)lds;
  const f16* Rb = (const f16*)(WS(p) + OFF_R);
  const f16* Kb = (const f16*)(WS(p) + OFF_K);
  const f16* Vb = (const f16*)(WS(p) + OFF_V);
  const float* INVN = (const float*)(WS(p) + OFF_INVN);
  const int tid = TID();
  const int lane = tid & 63, wave = tid >> 6;
  for (int item = BID(); item < 256; item += gridDim.x) {
    const int chain = item >> 1, half = item & 1;
    const int d = chain >> 6, b = (chain >> 3) & 7, h = chain & 7;
    const f16* Eb = (const f16*)(WS(p) + OFF_EH) + (size_t)d * TA * 512;
    const f16* Ab = (const f16*)(WS(p) + OFF_AR) + (size_t)d * TA * 512;
    f16* Yb = (f16*)(WS(p) + (d == 0 ? OFF_YS0 : OFF_YS1));
    const int lstep = tid >> 4, lkq = tid & 15;
    const int cb = h * 64 + lkq * 4;
    const float4 kkw = *(const float4*)(p.k_k + l * 512 + cb);
    const float4 kaw = *(const float4*)(p.k_a + l * 512 + cb);
    const int vcol = h * 64 + half * 32 + lkq * 2;
    const int rl = wave * 4 + (lane >> 4), kq = lane & 15;
    f32x2 SA = f32x2{0.f, 0.f}, SB = f32x2{0.f, 0.f};
    f16x4 kv, rv, ev, av;
    __attribute__((ext_vector_type(2))) _Float16 vv2;
    float invn;
    auto issue = [&](int blk) {
      const int tok = scan_token(d, b, blk * TB + lstep);
      const size_t o = (size_t)tok * 512 + cb;
      kv = *(const f16x4*)(Kb + o); rv = *(const f16x4*)(Rb + o);
      ev = *(const f16x4*)(Eb + o); av = *(const f16x4*)(Ab + o);
      vv2 = *(const __attribute__((ext_vector_type(2))) _Float16*)(Vb + (size_t)tok * 512 + vcol);
      invn = INVN[(size_t)tok * 8 + h];
    };
    auto commit = [&](int blk) {
      float* sg = st + (blk & 1) * ST_FLOATS;
      const float k0 = (float)kv[0], k1 = (float)kv[1], k2 = (float)kv[2], k3 = (float)kv[3];
      const float a0 = (float)av[0], a1 = (float)av[1], a2 = (float)av[2], a3 = (float)av[3];
      const float q0 = k0 * kkw.x * invn, q1 = k1 * kkw.y * invn, q2 = k2 * kkw.z * invn, q3 = k3 * kkw.w * invn;
      float* base = sg + lstep * 320 + lkq * 4;
      *(float4*)(base + 0) = float4{__expf(-(float)ev[0]), __expf(-(float)ev[1]), __expf(-(float)ev[2]), __expf(-(float)ev[3])};
      *(float4*)(base + 64) = float4{q0, q1, q2, q3};
      *(float4*)(base + 128) = float4{q0 * a0, q1 * a1, q2 * a2, q3 * a3};
      *(float4*)(base + 192) = float4{k0 * (1.f + (a0 - 1.f) * kaw.x), k1 * (1.f + (a1 - 1.f) * kaw.y),
                                      k2 * (1.f + (a2 - 1.f) * kaw.z), k3 * (1.f + (a3 - 1.f) * kaw.w)};
      *(float4*)(base + 256) = float4{(float)rv[0], (float)rv[1], (float)rv[2], (float)rv[3]};
      *(float2*)(sg + ST_VEC + lstep * 32 + lkq * 2) = float2{(float)vv2[0], (float)vv2[1]};
    };
    auto store_y = [&](int blk) {
      const float* sg = st + (blk & 1) * ST_FLOATS;
      const int tok = scan_token(d, b, blk * TB + lstep);
      const float2 yv = *(const float2*)(sg + ST_VEC + TB * 32 + lstep * 32 + lkq * 2);
      __attribute__((ext_vector_type(2))) _Float16 o;
      o[0] = f2h(yv.x); o[1] = f2h(yv.y);
      *(__attribute__((ext_vector_type(2))) _Float16*)(Yb + (size_t)tok * 512 + vcol) = o;
    };
    __syncthreads();
    issue(0);
    commit(0);
    __syncthreads();
    for (int blk = 0; blk < NBLK; ++blk) {
      const bool more = blk + 1 < NBLK;
      if (more) issue(blk + 1);
      {
        float* sg = st + (blk & 1) * ST_FLOATS;
        const float* vb = sg + ST_VEC;
        float* yb = sg + ST_VEC + TB * 32;
        float ysel0 = 0.f, ysel1 = 0.f;
        const float* base0 = sg + kq * 4;
        f32x4 w4 = *(const f32x4*)(base0 + 0);
        f32x4 q4 = *(const f32x4*)(base0 + 64);
        f32x4 a4 = *(const f32x4*)(base0 + 128);
        f32x4 d4 = *(const f32x4*)(base0 + 192);
        f32x4 r4 = *(const f32x4*)(base0 + 256);
        float vv = vb[rl];
#pragma unroll
        for (int u = 0; u < TB; ++u) {
          f32x4 nw4, nq4, na4, nd4, nr4;
          float nvv;
          if (u + 1 < TB) {
            const float* nb = base0 + (u + 1) * 320;
            nw4 = *(const f32x4*)(nb + 0);
            nq4 = *(const f32x4*)(nb + 64);
            na4 = *(const f32x4*)(nb + 128);
            nd4 = *(const f32x4*)(nb + 192);
            nr4 = *(const f32x4*)(nb + 256);
            nvv = vb[(u + 1) * 32 + rl];
          }
          const f32x2 vv2 = f32x2{vv, vv};
          f32x2 pp = SA * q4.xy;
          pp = __builtin_elementwise_fma(SB, q4.zw, pp);
          const float sa = red16(pp.x + pp.y);
          const f32x2 nsa = f32x2{-sa, -sa};
          f32x2 tA = SA * w4.xy;
          f32x2 tB = SB * w4.zw;
          tA = __builtin_elementwise_fma(vv2, d4.xy, tA);
          tB = __builtin_elementwise_fma(vv2, d4.zw, tB);
          SA = __builtin_elementwise_fma(nsa, a4.xy, tA);
          SB = __builtin_elementwise_fma(nsa, a4.zw, tB);
          f32x2 yy = SA * r4.xy;
          yy = __builtin_elementwise_fma(SB, r4.zw, yy);
          const float y = red16(yy.x + yy.y);
          if (u < 16) ysel0 = (u == kq) ? y : ysel0;
          else ysel1 = ((u - 16) == kq) ? y : ysel1;
          if (u + 1 < TB) { w4 = nw4; q4 = nq4; a4 = na4; d4 = nd4; r4 = nr4; vv = nvv; }
        }
        yb[kq * 32 + rl] = ysel0;
        yb[(16 + kq) * 32 + rl] = ysel1;
      }
      if (more) commit(blk + 1);
      __syncthreads();
      store_y(blk);
    }
  }
}

__device__ void proj_phase(const Params& p, char* lds) {
  const u16* H = (const u16*)(WS(p) + OFF_EH);
  const u16* WinT = (const u16*)(WS(p) + OFF_WTA + WO_IN);
  u16* FIN = (u16*)(WS(p) + OFF_FIN);
  f16* RW = (f16*)(WS(p) + OFF_RW);
  constexpr int MT = TA / 256, NT = 19;
  for (int tile = BID(); tile < MT * NT; tile += gridDim.x) {
    const int mt = tile / NT, nt = tile % NT;
    f32x4 acc[4][4];
    acc_zero(acc);
    gemm_loop(acc, H + (size_t)mt * 256 * 1024, 1024, WinT + (size_t)nt * 128 * 1024, 1024, 1024, lds);
    const int m0 = mt * 256, n0 = nt * 128;
    if (n0 < 512) {
      epi_apply(acc, lds, [&](int r, int c, float (&v)[8]) { *(u16x8*)(FIN + (size_t)(m0 + r) * 512 + n0 + c) = pack_bf8(v); });
    } else {
      epi_apply(acc, lds, [&](int r, int c, float (&v)[8]) { *(f16x8*)(RW + (size_t)(m0 + r) * 1920 + (n0 - 512) + c) = pack_h8(v); });
    }
  }
}

__device__ void dft1_phase(const Params& p, int l, char* lds) {
  const u16* FIN = (const u16*)(WS(p) + OFF_FIN);
  const u16* TW = (const u16*)(WS(p) + OFF_AR) + DM_TW;
  u16* UCS = (u16*)(WS(p) + OFF_EH);
  u16* UCSC = UCS + (size_t)32 * 256 * 2048;
  const int ntiles = 512 + (l == 0 ? 64 : 0);
  for (int tile = BID(); tile < ntiles; tile += gridDim.x) {
    const u16* bt;
    u16* o;
    int ldo;
    if (tile < 512) {
      const int bg = tile >> 4, nt = tile & 15, b = bg >> 2, g = bg & 3;
      bt = FIN + (size_t)(b * 2048 + nt * 128) * 512 + g * 128;
      o = UCS + (size_t)bg * 256 * 2048 + nt * 128;
      ldo = 2048;
    } else {
      const int t2 = tile - 512;
      const int bg = t2 >> 1, nt = t2 & 1, b = bg >> 2, g = bg & 3;
      bt = FIN + (size_t)(TL + b * 256 + nt * 128) * 512 + g * 128;
      o = UCSC + (size_t)bg * 256 * 256 + nt * 128;
      ldo = 256;
    }
    f32x4 acc[4][4];
    acc_zero(acc);
    gemm_loop(acc, TW, 128, bt, 512, 128, lds);
    epi_apply(acc, lds, [&](int r, int c, float (&v)[8]) { *(u16x8*)(o + (size_t)r * ldo + c) = pack_bf8(v); });
  }
}

__device__ void dft2_phase(const Params& p, int l, char* lds) {
  const u16* DM = (const u16*)(WS(p) + OFF_AR);
  const u16* UCS = (const u16*)(WS(p) + OFF_EH);
  const u16* UCSC = UCS + (size_t)32 * 256 * 2048;
  u16* FOUT = (u16*)(WS(p) + OFF_FIN);
  const int ntiles = 256 + (l == 0 ? 32 : 0);
  for (int tile = BID(); tile < ntiles; tile += gridDim.x) {
    const u16 *a0, *a1, *bt;
    u16* o;
    int Ld;
    float sc;
    if (tile < 256) {
      const int b = tile >> 5, mt = (tile >> 2) & 7, g = tile & 3;
      Ld = 2048;
      bt = UCS + (size_t)((b * 4 + g) * 256) * 2048;
      a0 = DM + DM_C + (size_t)mt * 256 * 2048;
      a1 = DM + DM_NS + (size_t)mt * 256 * 2048;
      o = FOUT + (size_t)(b * 2048 + mt * 256) * 512 + g * 128;
      sc = 1.f / 512.f;
    } else {
      const int t2 = tile - 256;
      const int b = t2 >> 2, g = t2 & 3;
      Ld = 256;
      bt = UCSC + (size_t)((b * 4 + g) * 256) * 256;
      a0 = DM + DM_CC;
      a1 = DM + DM_NSC;
      o = FOUT + (size_t)(TL + b * 256) * 512 + g * 128;
      sc = 0.005524271728019903f;
    }
    f32x4 acc[4][4];
    acc_zero(acc);
#pragma unroll 1
    for (int seg = 0; seg < 2; ++seg)
      gemm_loop(acc, seg == 0 ? a0 : a1, Ld, bt + (size_t)seg * 128 * Ld, Ld, Ld, lds);
    epi_apply(acc, lds, [&](int r, int c, float (&v)[8]) {
#pragma unroll
      for (int j = 0; j < 8; ++j) v[j] *= sc;
      *(u16x8*)(o + (size_t)r * 512 + c) = pack_bf8(v);
    });
  }
}

__device__ void lora_phase(const Params& p, int l, char* lds) {
  const u16* LORA = (const u16*)(WS(p) + OFF_LORA);
  const u16* WupT = (const u16*)(WS(p) + OFF_WTA + WO_WUP);
  const u16* AupT = (const u16*)(WS(p) + OFF_WTA + WO_AUP);
  constexpr int MT = TA / 256;
  for (int tile = BID(); tile < 4 * MT * 4; tile += gridDim.x) {
    const int which = tile / (MT * 4), rem = tile % (MT * 4), mt = rem >> 2, nt = rem & 3;
    const int d = which & 1;
    f32x4 acc[4][4];
    acc_zero(acc);
    const u16* bt = (which < 2 ? WupT : AupT) + (size_t)d * 512 * 64 + (size_t)nt * 128 * 64;
    gemm_loop(acc, LORA + (size_t)mt * 256 * 256 + which * 64, 256, bt, 64, 64, lds);
    f16* o = (f16*)(WS(p) + (which < 2 ? OFF_EH : OFF_AR)) + (size_t)d * TA * 512 + (size_t)mt * 256 * 512 + nt * 128;
    const float* bias = (which < 2 ? p.w0 : p.a0) + (size_t)l * 1024 + d * 512 + nt * 128;
    const float mul = (which < 2) ? 0.6065306597126334f : 1.f;
    epi_apply(acc, lds, [&](int r, int c, float (&v)[8]) {
      const float4 b0 = *(const float4*)(bias + c), b1 = *(const float4*)(bias + c + 4);
      const float bb[8] = {b0.x, b0.y, b0.z, b0.w, b1.x, b1.y, b1.z, b1.w};
#pragma unroll
      for (int j = 0; j < 8; ++j) v[j] = sigmoidf_(bb[j] + v[j]) * mul;
      *(f16x8*)(o + (size_t)r * 512 + c) = pack_h8(v);
    });
  }
}

__device__ void g_phase(const Params& p, int ntok, char* lds) {
  const u16* GDS = (const u16*)(WS(p) + OFF_GDS);
  const u16* GupT = (const u16*)(WS(p) + OFF_WTA + WO_GUP);
  u16* Z = (u16*)(WS(p) + OFF_YS0);
  const int MT = ntok / 256;
  for (int tile = BID(); tile < MT * 4; tile += gridDim.x) {
    const int mt = tile >> 2, nt = tile & 3;
    f32x4 acc[4][4];
    acc_zero(acc);
    gemm_loop(acc, GDS + (size_t)mt * 256 * 128, 128, GupT + (size_t)nt * 128 * 128, 128, 128, lds);
    u16* o = Z + (size_t)mt * 256 * 512 + nt * 128;
    epi_apply(acc, lds, [&](int r, int c, float (&v)[8]) {
      u16x8* q = (u16x8*)(o + (size_t)r * 512 + c);
      const u16x8 z = *q;
#pragma unroll
      for (int j = 0; j < 8; ++j) v[j] *= bf2f(z[j]);
      *q = pack_bf8(v);
    });
  }
}

__device__ void merge_phase(const Params& p, int ntok, char* lds) {
  const u16* H = (const u16*)(WS(p) + OFF_EH);
  const u16* WinT = (const u16*)(WS(p) + OFF_WTA + WO_IN);
  const u16* FOUT = (const u16*)(WS(p) + OFF_FIN);
  const u16* Z = (const u16*)(WS(p) + OFF_YS0);
  const u16* WfuT = (const u16*)(WS(p) + OFF_WTA + WO_FU);
  const u16* WruT = (const u16*)(WS(p) + OFF_WTA + WO_RU);
  u16* MG = (u16*)(WS(p) + OFF_AR);
  u16* SG = (u16*)(WS(p) + OFF_YS1);
  const int MT = ntok / 256;
  for (int tile = BID(); tile < MT * 8; tile += gridDim.x) {
    const int mt = tile >> 3, nt = tile & 7;
    u16* o = MG + (size_t)mt * 256 * 1024 + nt * 128;
    u16* sg = SG + (size_t)mt * 256 * 1024 + nt * 128;
#pragma unroll 1
    for (int sub = 0; sub < 4; ++sub) {
      const int pass = sub >> 1;
      const bool gate = (sub & 1) == 0;
      const u16* A = gate ? (H + (size_t)mt * 256 * 1024) : ((pass == 0 ? FOUT : Z) + (size_t)mt * 256 * 512);
      const u16* Bt = gate ? (WinT + (size_t)(2432 + pass * 1024 + nt * 128) * 1024)
                           : ((pass == 0 ? WfuT : WruT) + (size_t)nt * 128 * 512);
      const int K = gate ? 1024 : 512;
      f32x4 acc[4][4];
      acc_zero(acc);
      gemm_loop(acc, A, K, Bt, K, K, lds);
      epi_apply(acc, lds, [&](int r, int c, float (&v)[8]) {
        u16x8* qs = (u16x8*)(sg + (size_t)r * 1024 + c);
        u16x8* qo = (u16x8*)(o + (size_t)r * 1024 + c);
        if (gate) {
#pragma unroll
          for (int j = 0; j < 8; ++j) v[j] = sigmoidf_(v[j]);
          *qs = pack_bf8(v);
        } else {
          const u16x8 sv = *qs;
#pragma unroll
          for (int j = 0; j < 8; ++j) v[j] *= bf2f(sv[j]);
          if (pass == 1) {
            const u16x8 ov = *qo;
#pragma unroll
            for (int j = 0; j < 8; ++j) v[j] += bf2f(ov[j]);
          }
          *qo = pack_bf8(v);
        }
      });
    }
  }
}

__device__ void resid_gemm_phase(const Params& p, int l, int ntok, const u16* A, int K, const u16* Bt, int gate_off, char* lds) {
  const float* MOD = (const float*)(WS(p) + OFF_MOD);
  float* XC = (float*)(WS(p) + OFF_XC);
  const int MT = ntok / 256;
  for (int tile = BID(); tile < MT * 8; tile += gridDim.x) {
    const int mt = tile >> 3, nt = tile & 7;
    f32x4 acc[4][4];
    acc_zero(acc);
    gemm_loop(acc, A + (size_t)mt * 256 * K, K, Bt + (size_t)nt * 128 * K, K, K, lds);
    const int m0 = mt * 256, n0 = nt * 128;
    epi_apply(acc, lds, [&](int r, int c, float (&v)[8]) {
      const int row = m0 + r, col = n0 + c;
      float* q = (row < TL) ? (p.out + (size_t)row * 1024 + col) : (XC + (size_t)(row - TL) * 1024 + col);
      const float* gp = MOD + ((size_t)l * 9 + ((row < TL) ? (row >> 11) : 8)) * 6144 + gate_off + col;
      const float4 g0 = *(const float4*)gp, g1 = *(const float4*)(gp + 4);
      float4 x0 = *(const float4*)q, x1 = *(const float4*)(q + 4);
      x0.x += g0.x * v[0]; x0.y += g0.y * v[1]; x0.z += g0.z * v[2]; x0.w += g0.w * v[3];
      x1.x += g1.x * v[4]; x1.y += g1.y * v[5]; x1.z += g1.z * v[6]; x1.w += g1.w * v[7];
      *(float4*)q = x0; *(float4*)(q + 4) = x1;
    });
  }
}

__device__ void mlp_up_phase(const Params& p, int ntok, char* lds) {
  const u16* H2 = (const u16*)(WS(p) + OFF_EH);
  const u16* W1T = (const u16*)(WS(p) + OFF_W1T);
  u16* HID = (u16*)(WS(p) + OFF_HID);
  const int MT = ntok / 256;
  for (int tile = BID(); tile < MT * 32; tile += gridDim.x) {
    const int mt = tile >> 5, nt = tile & 31;
    f32x4 acc[4][4];
    acc_zero(acc);
    gemm_loop(acc, H2 + (size_t)mt * 256 * 1024, 1024, W1T + (size_t)nt * 128 * 1024, 1024, 1024, lds);
    u16* o = HID + (size_t)mt * 256 * 4096 + nt * 128;
    epi_apply(acc, lds, [&](int r, int c, float (&v)[8]) {
#pragma unroll
      for (int j = 0; j < 8; ++j) { const float t = fmaxf(v[j], 0.f); v[j] = t * t; }
      *(u16x8*)(o + (size_t)r * 4096 + c) = pack_bf8(v);
    });
  }
}

#define XB_TMO      128
#define XB_XCNT(j)  (256  + 64 * (j))
#define XB_XSUB(j)  (1280 + 64 * (j))
#define XB_XGEN(j)  (2304 + 64 * (j))
#define XB_TOP      3328
#define XB_TOPGEN   3392
#define XCD_BAR_WORDS 3456
#define XB_SPIN_CAP (1u << 18)
#define LAS __attribute__((address_space(3)))

__device__ __forceinline__ unsigned xb_ld(unsigned* p)              { return __hip_atomic_load(p, __ATOMIC_RELAXED, __HIP_MEMORY_SCOPE_AGENT); }
__device__ __forceinline__ unsigned xb_add(unsigned* p, unsigned v) { return __hip_atomic_fetch_add(p, v, __ATOMIC_RELAXED, __HIP_MEMORY_SCOPE_AGENT); }
__device__ __forceinline__ unsigned xb_xcc_id() { return (unsigned)__builtin_amdgcn_s_getreg((3 << 11) | 20) & 0xFu; }
#define XB_SPIN(cond, bar) do { unsigned _sp = 0; while (cond) { __builtin_amdgcn_s_sleep(1); \
    if ((++_sp & 255u) == 0u) { if (xb_ld(&(bar)[XB_TMO])) break; if (_sp > XB_SPIN_CAP) { atomicAdd(&(bar)[XB_TMO], 1u); break; } } } } while (0)

struct XcdBarrier { unsigned* bar; unsigned x; volatile LAS unsigned* st; };

__device__ __forceinline__ XcdBarrier xcd_barrier_post(unsigned* bar, volatile LAS unsigned* st) {
    XcdBarrier b; b.bar = bar; b.x = xb_xcc_id(); b.st = st;
    if (threadIdx.x == 0) (void)xb_add(&bar[XB_XCNT(b.x)], 1u);
    return b;
}
__device__ __forceinline__ void xcd_barrier_complete(unsigned* bar, unsigned x, unsigned& nloc, unsigned& nx) {
    const unsigned G = gridDim.x * gridDim.y * gridDim.z;
    unsigned sum, cnt, mine, sp = 0u;
    for (;;) {
        sum = 0u; cnt = 0u; mine = 0u;
#pragma unroll
        for (unsigned j = 0; j < 16; ++j) { const unsigned c = xb_ld(&bar[XB_XCNT(j)]); sum += c; cnt += (c > 0u) ? 1u : 0u; mine = (j == x) ? c : mine; }
        if (sum == G) break;
        __builtin_amdgcn_s_sleep(1);
        if ((++sp & 255u) == 0u) { if (xb_ld(&bar[XB_TMO])) break; if (sp > XB_SPIN_CAP) { atomicAdd(&bar[XB_TMO], 1u); break; } }
    }
    nloc = mine > 0u ? mine : 1u; nx = cnt > 0u ? cnt : 1u;
}
__device__ __forceinline__ void xcd_barrier(const XcdBarrier& b) {
    asm volatile("s_waitcnt vmcnt(0)" ::: "memory");
    __syncthreads();
    if (threadIdx.x == 0) {
        unsigned* bar = b.bar;
        __builtin_amdgcn_s_waitcnt(0);
        unsigned nloc = b.st[0], nx = b.st[1];
        if (nloc == 0u) { xcd_barrier_complete(bar, b.x, nloc, nx); b.st[0] = nloc; b.st[1] = nx; }
        const unsigned old = xb_add(&bar[XB_XSUB(b.x)], 1u);
        const unsigned gen = old / nloc;
        if (old + 1u == (gen + 1u) * nloc) {
            __builtin_amdgcn_fence(__ATOMIC_RELEASE, "agent");
            asm volatile("s_waitcnt vmcnt(0)" ::: "memory");
            const unsigned og = xb_add(&bar[XB_TOP], 1u);
            const unsigned tg = og / nx;
            if (og + 1u == (tg + 1u) * nx) xb_add(&bar[XB_TOPGEN], 1u);
            else XB_SPIN(xb_ld(&bar[XB_TOPGEN]) == tg, bar);
            __builtin_amdgcn_fence(__ATOMIC_ACQUIRE, "agent");
            xb_add(&bar[XB_XGEN(b.x)], 1u);
            asm volatile("s_waitcnt vmcnt(0)" ::: "memory");
        } else {
            XB_SPIN(xb_ld(&bar[XB_XGEN(b.x)]) == gen, bar);
            __builtin_amdgcn_fence(__ATOMIC_ACQUIRE, "agent");
            asm volatile("s_waitcnt vmcnt(0)" ::: "memory");
        }
    }
    __syncthreads();
}

constexpr int PH_PER_LAYER = 13;
constexpr int N_PHASES = 1 + 2 * PH_PER_LAYER + 1;

__device__ void run_phase(const Params& p, int ph, char* lds) {
  if (ph == 0) {
    copy_f4(p.x, p.out, (size_t)TL * 1024 / 4);
    copy_f4(p.ctx, (float*)(WS(p) + OFF_XC), (size_t)TC * 1024 / 4);
    mod_phase(p, lds);
    return;
  }
  if (ph == N_PHASES - 1) { final_norm(p); return; }
  const int l = (ph - 1) / PH_PER_LAYER, q = (ph - 1) % PH_PER_LAYER;
  const int ntok = (l == 0) ? TA : TL;
  switch (q) {
    case 0:
      conv_phase(p, l, 0, lds);
      dftm_gen(p);
      normmod_phase(p, l, 0, TA, (u16*)(WS(p) + OFF_EH));
      break;
    case 1: proj_phase(p, lds); break;
    case 2: dft1_phase(p, l, lds); prep3a_phase(p, l); break;
    case 3: dft2_phase(p, l, lds); break;
    case 4: lora_phase(p, l, lds); break;
    case 5: scan_phase(p, l, lds); break;
    case 6:
      post5a_phase(p, l, ntok);
      normmod_phase(p, l, 0, ntok, (u16*)(WS(p) + OFF_EH));
      conv_phase(p, l, 1, lds);
      break;
    case 7: g_phase(p, ntok, lds); break;
    case 8: merge_phase(p, ntok, lds); break;
    case 9: resid_gemm_phase(p, l, ntok, (const u16*)(WS(p) + OFF_AR), 1024, (const u16*)(WS(p) + OFF_WTA + WO_OUT), 2048, lds); break;
    case 10: normmod_phase(p, l, 1, ntok, (u16*)(WS(p) + OFF_EH)); break;
    case 11: mlp_up_phase(p, ntok, lds); break;
    case 12: resid_gemm_phase(p, l, ntok, (const u16*)(WS(p) + OFF_HID), 4096, (const u16*)(WS(p) + OFF_W2T), 5120, lds); break;
  }
}

extern "C" __global__ void __launch_bounds__(NTHREADS) fwd_megakernel(Params p) {
  extern __shared__ __attribute__((aligned(16))) char lds[];
#if ONE_LAUNCH
  cg::grid_group grid = cg::this_grid();
  __shared__ uint4 xb_words;
  if (threadIdx.x == 0) xb_words = make_uint4(0u, 0u, 0u, 0u);
  __syncthreads();
  XcdBarrier xb = xcd_barrier_post((unsigned*)(p.ws + OFF_BAR), (volatile LAS unsigned*)&xb_words);
#ifndef REP_MASK
#define REP_MASK 0
#endif
  int ph = p.ph_lo, rep = 0;
  while (ph < p.ph_hi) {
    run_phase(p, ph, lds);
    const bool first = (ph == p.ph_lo) && (rep == 0);
    const bool again = (rep == 0) && ph >= 1 && ph < N_PHASES - 1 && ((REP_MASK >> ((ph - 1) % PH_PER_LAYER)) & 1);
    if (again) rep = 1; else { rep = 0; ++ph; }
    if (ph < p.ph_hi) {
      if (first) grid.sync();
      else xcd_barrier(xb);
    }
  }
#else
  for (int ph = p.ph_lo; ph < p.ph_hi; ++ph) run_phase(p, ph, lds);
#endif
}

extern "C" void kernel_launch(void* const* d_in, const int* in_sizes, int n_in, void* d_out, int out_size, void* d_ws,
                              size_t ws_size, hipStream_t stream) {
  static int grid = 0;
  if (grid == 0) {
    if (ws_size < WS_NEED) { fprintf(stderr, "kernel_launch: workspace too small: %zu < %zu\n", ws_size, (size_t)WS_NEED); grid = -1; return; }
    int dev = 0, cus = 0, per_cu = 0;
    hipGetDevice(&dev);
    hipDeviceGetAttribute(&cus, hipDeviceAttributeMultiprocessorCount, dev);
    hipFuncSetAttribute((const void*)fwd_megakernel, hipFuncAttributeMaxDynamicSharedMemorySize, LDS_BYTES);
    hipOccupancyMaxActiveBlocksPerMultiprocessor(&per_cu, (const void*)fwd_megakernel, NTHREADS, LDS_BYTES);
    if (per_cu < 1) per_cu = 1;
    grid = cus;
    (void)hipGetLastError();
  }
  if (grid < 0) return;
  Params p{};
  const float** pp = (const float**)&p;
  for (int i = 0; i < 26; ++i) pp[i] = (const float*)d_in[i];
  p.out = (float*)d_out;
  p.ws = (char*)d_ws;
#if ONE_LAUNCH
  (void)hipMemsetAsync((char*)d_ws + OFF_BAR, 0, XCD_BAR_WORDS * sizeof(unsigned), stream);
  p.ph_lo = 0; p.ph_hi = N_PHASES;
  void* args[] = {&p};
  hipError_t e = hipLaunchCooperativeKernel((const void*)fwd_megakernel, dim3(grid), dim3(NTHREADS), args, LDS_BYTES, stream);
  if (e != hipSuccess) fprintf(stderr, "cooperative launch failed: %s (grid %d)\n", hipGetErrorString(e), grid);
#else
  for (int ph = 0; ph < N_PHASES; ++ph) {
    p.ph_lo = ph; p.ph_hi = ph + 1;
    hipLaunchKernelGGL(fwd_megakernel, dim3(grid), dim3(NTHREADS), LDS_BYTES, stream, p);
  }
#endif
}
```

```cpp
#include <hip/hip_runtime.h>
#include <hip/hip_cooperative_groups.h>
#include <cstdio>
#include <cstdint>
#include <cstddef>
namespace cg = cooperative_groups;

typedef unsigned short u16;
typedef _Float16 f16;
using bf16x8 = __attribute__((ext_vector_type(8))) short;
using f32x4 = __attribute__((ext_vector_type(4))) float;
using f32x2 = __attribute__((ext_vector_type(2))) float;
using f16x8 = __attribute__((ext_vector_type(8))) _Float16;
using f16x4 = __attribute__((ext_vector_type(4))) _Float16;
using u16x8 = __attribute__((ext_vector_type(8))) unsigned short;

#ifndef ONE_LAUNCH
#define ONE_LAUNCH 1
#endif

constexpr int D = 1024, NB = 8, L = 2048, LC = 256, TL = 16384, TC = 2048, TA = 18432;
constexpr int NTHREADS = 512;
constexpr int LDT = 72;
constexpr int STAGE_ELEMS = (256 + 128) * LDT;
constexpr int LDS_BYTES = 2 * STAGE_ELEMS * 2;

constexpr size_t MiB = (size_t)1 << 20;
constexpr size_t OFF_MOD = 0;
constexpr size_t OFF_XC = 1 * MiB;
constexpr size_t OFF_WTA = 9 * MiB;
constexpr size_t OFF_FIN = 23 * MiB;
constexpr size_t OFF_EH = 41 * MiB;
constexpr size_t OFF_RW = 77 * MiB;
constexpr size_t OFF_W1T = 77 * MiB;
constexpr size_t OFF_W2T = 85 * MiB;
constexpr size_t OFF_YS0 = 93 * MiB;
constexpr size_t OFF_YS1 = 111 * MiB;
constexpr size_t OFF_HID = 93 * MiB;
constexpr size_t OFF_R = 144 * MiB + MiB / 2;
constexpr size_t OFF_K = OFF_R + 18 * MiB;
constexpr size_t OFF_V = OFF_K + 18 * MiB;
constexpr size_t OFF_AR = OFF_V + 18 * MiB;
constexpr size_t OFF_LORA = OFF_AR + 36 * MiB;
constexpr size_t OFF_GDS = OFF_LORA + 9 * MiB;
constexpr size_t OFF_INVN = OFF_GDS + 4 * MiB + MiB / 2;
constexpr size_t OFF_BAR = 250 * MiB;
constexpr size_t WS_NEED = OFF_BAR + MiB;
constexpr size_t WO_IN = 0, WO_FU = 9175040, WO_RU = 10223616, WO_OUT = 11272192, WO_WUP = 13369344, WO_AUP = 13500416, WO_GUP = 13631488;
constexpr size_t DM_C = 0, DM_NS = (size_t)2048 * 2048, DM_CC = (size_t)2 * 2048 * 2048, DM_NSC = DM_CC + 65536, DM_TW = DM_NSC + 65536;

struct Params {
  const float *x, *c, *ctx, *c_ctx, *w_mod, *b_mod, *norm1, *norm2, *w_in, *mu_shift, *w0, *w_up, *a0, *a_up, *g_up,
      *k_k, *k_a, *r_k, *ln_x_w, *ln_x_b, *w_fourier_up, *w_rwkv_up, *w_out, *mlp_w1, *mlp_w2, *norm_f;
  float* out;
  char* ws;
  int ph_lo, ph_hi;
};
__device__ __forceinline__ char* WS(const Params& p) { int z = 0; asm volatile("" : "+s"(z)); return p.ws + z; }


__device__ __forceinline__ int TID() { int t = threadIdx.x; asm volatile("" : "+v"(t)); return t; }
__device__ __forceinline__ int BID() { int t = blockIdx.x; asm volatile("" : "+s"(t)); return t; }
__device__ __forceinline__ u16 f2bf(float f) {
  uint32_t u = __float_as_uint(f);
  u += 0x7fffu + ((u >> 16) & 1u);
  return (u16)(u >> 16);
}
__device__ __forceinline__ float bf2f(u16 h) { return __uint_as_float(((uint32_t)h) << 16); }
__device__ __forceinline__ float sigmoidf_(float x) { return 1.f / (1.f + __expf(-x)); }
__device__ __forceinline__ f16 f2h(float v) { v = fminf(fmaxf(v, -60000.f), 60000.f); return (f16)v; }

template <int CTRL>
__device__ __forceinline__ float dpp_f(float x) {
  return __int_as_float(__builtin_amdgcn_update_dpp(0, __float_as_int(x), CTRL, 0xf, 0xf, true));
}
__device__ __forceinline__ float red8(float x) {
  x += dpp_f<0xB1>(x);
  x += dpp_f<0x4E>(x);
  x += dpp_f<0x141>(x);
  return x;
}
__device__ __forceinline__ float wave_sum(float v) {
#pragma unroll
  for (int o = 32; o > 0; o >>= 1) v += __shfl_xor(v, o, 64);
  return v;
}

__device__ __forceinline__ void gemm_loop(f32x4 (&acc)[4][4], const u16* __restrict__ A, int lda,
                                          const u16* __restrict__ Bt, int ldb, int K, char* lds) {
  const int tid = TID();
  const int lane = tid & 63, wave = tid >> 6;
  const int wm = wave >> 1, wn = wave & 1;
  u16* s0 = (u16*)lds;
  const int lr = tid >> 3, lc = (tid & 7) * 8;
  const u16* ap0 = A + (size_t)lr * lda + lc;
  const u16* ap1 = ap0 + (size_t)64 * lda;
  const u16* ap2 = ap0 + (size_t)128 * lda;
  const u16* ap3 = ap0 + (size_t)192 * lda;
  const u16* bp0 = Bt + (size_t)lr * ldb + lc;
  const u16* bp1 = bp0 + (size_t)64 * ldb;
  const int KT = K >> 6;
  const int wofa = lr * LDT + lc;
  const int wofb = 256 * LDT + wofa;
  const int arow = (wm * 64 + (lane & 15)) * LDT + (lane >> 4) * 8;
  const int brow = (wn * 64 + (lane & 15)) * LDT + (lane >> 4) * 8;
#define G_LOAD(S, kt_) do { const int ko_ = (kt_) * 64; \
    S##a0 = *(const uint4*)(ap0 + ko_); S##a1 = *(const uint4*)(ap1 + ko_); S##a2 = *(const uint4*)(ap2 + ko_); S##a3 = *(const uint4*)(ap3 + ko_); \
    S##b0 = *(const uint4*)(bp0 + ko_); S##b1 = *(const uint4*)(bp1 + ko_); } while (0)
#define G_WRITE(S, st_) do { u16* w_ = s0 + (st_) * STAGE_ELEMS; \
    *(uint4*)(w_ + wofa) = S##a0; *(uint4*)(w_ + wofa + 64 * LDT) = S##a1; *(uint4*)(w_ + wofa + 128 * LDT) = S##a2; *(uint4*)(w_ + wofa + 192 * LDT) = S##a3; \
    *(uint4*)(w_ + wofb) = S##b0; *(uint4*)(w_ + wofb + 64 * LDT) = S##b1; } while (0)
#define MF(i, j, av, bv) acc[i][j] = __builtin_amdgcn_mfma_f32_16x16x32_bf16(av, bv, acc[i][j], 0, 0, 0)
#define G_COMPUTE(st_) do { const u16* sa = s0 + (st_) * STAGE_ELEMS; const u16* sb = sa + 256 * LDT; \
    _Pragma("unroll") for (int ks = 0; ks < 2; ++ks) { \
      const bf16x8 a0 = *(const bf16x8*)(sa + arow + ks * 32); \
      const bf16x8 a1 = *(const bf16x8*)(sa + arow + 16 * LDT + ks * 32); \
      const bf16x8 a2 = *(const bf16x8*)(sa + arow + 32 * LDT + ks * 32); \
      const bf16x8 a3 = *(const bf16x8*)(sa + arow + 48 * LDT + ks * 32); \
      const bf16x8 b0 = *(const bf16x8*)(sb + brow + ks * 32); \
      const bf16x8 b1 = *(const bf16x8*)(sb + brow + 16 * LDT + ks * 32); \
      const bf16x8 b2 = *(const bf16x8*)(sb + brow + 32 * LDT + ks * 32); \
      const bf16x8 b3 = *(const bf16x8*)(sb + brow + 48 * LDT + ks * 32); \
      MF(0, 0, a0, b0); MF(0, 1, a0, b1); MF(0, 2, a0, b2); MF(0, 3, a0, b3); \
      MF(1, 0, a1, b0); MF(1, 1, a1, b1); MF(1, 2, a1, b2); MF(1, 3, a1, b3); \
      MF(2, 0, a2, b0); MF(2, 1, a2, b1); MF(2, 2, a2, b2); MF(2, 3, a2, b3); \
      MF(3, 0, a3, b0); MF(3, 1, a3, b1); MF(3, 2, a3, b2); MF(3, 3, a3, b3); } } while (0)
  uint4 Pa0, Pa1, Pa2, Pa3, Pb0, Pb1, Qa0, Qa1, Qa2, Qa3, Qb0, Qb1;
  __syncthreads();
  G_LOAD(P, 0);
  G_WRITE(P, 0);
  if (KT == 1) {
    __syncthreads();
    G_COMPUTE(0);
    __syncthreads();
  } else if (KT == 2) {
    G_LOAD(P, 1);
    __syncthreads();
    G_COMPUTE(0);
    G_WRITE(P, 1);
    __syncthreads();
    G_COMPUTE(1);
    __syncthreads();
  } else {
    G_LOAD(P, 1);
    G_LOAD(Q, 2);
    __syncthreads();
    int kt = 0;
    for (; kt + 4 < KT; kt += 2) {
      G_COMPUTE(0);
      G_WRITE(P, 1);
      G_LOAD(P, kt + 3);
      __syncthreads();
      G_COMPUTE(1);
      G_WRITE(Q, 0);
      G_LOAD(Q, kt + 4);
      __syncthreads();
    }
    G_COMPUTE(0);
    G_WRITE(P, 1);
    G_LOAD(P, kt + 3);
    __syncthreads();
    G_COMPUTE(1);
    G_WRITE(Q, 0);
    __syncthreads();
    G_COMPUTE(0);
    G_WRITE(P, 1);
    __syncthreads();
    G_COMPUTE(1);
    __syncthreads();
  }
#undef G_LOAD
#undef G_WRITE
#undef G_COMPUTE
#undef MF
}

__device__ __forceinline__ void acc_zero(f32x4 (&acc)[4][4]) {
#pragma unroll
  for (int i = 0; i < 4; ++i)
#pragma unroll
    for (int j = 0; j < 4; ++j) acc[i][j] = f32x4{0.f, 0.f, 0.f, 0.f};
}

template <class F>
__device__ __forceinline__ void epi_apply(f32x4 (&acc)[4][4], char* lds, F f) {
  const int lane = TID() & 63, wave = TID() >> 6;
  const int wm = wave >> 1, wn = wave & 1;
  float* sw = (float*)lds + wave * (32 * 68);
#pragma unroll
  for (int hp = 0; hp < 2; ++hp) {
#pragma unroll
    for (int m2 = 0; m2 < 2; ++m2)
#pragma unroll
      for (int nf = 0; nf < 4; ++nf)
#pragma unroll
        for (int r = 0; r < 4; ++r)
          sw[(m2 * 16 + (lane >> 4) * 4 + r) * 68 + nf * 16 + (lane & 15)] = acc[hp * 2 + m2][nf][r];
    __builtin_amdgcn_wave_barrier();
#pragma unroll
    for (int i = 0; i < 4; ++i) {
      const int rr = i * 8 + (lane >> 3), cc = (lane & 7) * 8;
      const float4 a = *(const float4*)(sw + rr * 68 + cc), b = *(const float4*)(sw + rr * 68 + cc + 4);
      float v[8] = {a.x, a.y, a.z, a.w, b.x, b.y, b.z, b.w};
      f(wm * 64 + hp * 32 + rr, wn * 64 + cc, v);
    }
    __builtin_amdgcn_wave_barrier();
  }
}

__device__ __forceinline__ u16x8 pack_bf8(const float (&v)[8]) {
  u16x8 o;
#pragma unroll
  for (int j = 0; j < 8; ++j) o[j] = f2bf(v[j]);
  return o;
}
__device__ __forceinline__ f16x8 pack_h8(const float (&v)[8]) {
  f16x8 o;
#pragma unroll
  for (int j = 0; j < 8; ++j) o[j] = f2h(v[j]);
  return o;
}

__device__ void copy_f4(const float* __restrict__ src, float* __restrict__ dst, size_t n4) {
  const float4* s = (const float4*)src; float4* d = (float4*)dst;
  for (size_t i = (size_t)BID() * NTHREADS + TID(); i < n4; i += (size_t)gridDim.x * NTHREADS) d[i] = s[i];
}

__device__ void mod_phase(const Params& p, char* lds) {
  float* sl = (float*)lds;
  float* red = sl + 9 * 1024;
  float* MOD = (float*)(WS(p) + OFF_MOD);
  const int tid = TID(), lane = tid & 63, wave = tid >> 6;
  __syncthreads();
  for (int i = tid; i < 9 * 1024; i += NTHREADS) {
    float v = (i < 8 * 1024) ? p.c[i] : p.c_ctx[i - 8 * 1024];
    sl[i] = v * sigmoidf_(v);
  }
  __syncthreads();
  for (int item = BID(); item < 192; item += gridDim.x) {
    const int l = item / 96, n0 = (item % 96) * 64;
    const float* w = p.w_mod + (size_t)l * 1024 * 6144 + n0 + lane;
    float acc[9];
#pragma unroll
    for (int r = 0; r < 9; ++r) acc[r] = 0.f;
    const int kbeg = wave * 128;
#pragma unroll 8
    for (int k = kbeg; k < kbeg + 128; ++k) {
      float wv = w[(size_t)k * 6144];
#pragma unroll
      for (int r = 0; r < 9; ++r) acc[r] += sl[r * 1024 + k] * wv;
    }
#pragma unroll
    for (int r = 0; r < 9; ++r) red[(wave * 9 + r) * 64 + lane] = acc[r];
    __syncthreads();
    for (int i = tid; i < 9 * 64; i += NTHREADS) {
      int r = i >> 6, ln = i & 63;
      float s = 0.f;
#pragma unroll
      for (int w8 = 0; w8 < 8; ++w8) s += red[(w8 * 9 + r) * 64 + ln];
      MOD[((size_t)l * 9 + r) * 6144 + n0 + ln] = s + p.b_mod[(size_t)l * 6144 + n0 + ln];
    }
    __syncthreads();
  }
}

__device__ void convT_tile(const float* __restrict__ src, int K, int N, u16* __restrict__ dst, int t, char* lds) {
  float* tile = (float*)lds;
  const int tid = TID();
  const int nT = N >> 6;
  const int k0 = (t / nT) * 64, n0 = (t % nT) * 64;
  __syncthreads();
#pragma unroll
  for (int i = 0; i < 8; ++i) {
    int k = (tid >> 6) + 8 * i, n = tid & 63;
    tile[k * 65 + n] = src[(size_t)(k0 + k) * N + n0 + n];
  }
  __syncthreads();
  {
    int n = tid >> 3, kc = (tid & 7) * 8;
    u16x8 o;
#pragma unroll
    for (int j = 0; j < 8; ++j) o[j] = f2bf(tile[(kc + j) * 65 + n]);
    *(u16x8*)(dst + (size_t)(n0 + n) * K + k0 + kc) = o;
  }
}

__device__ void conv_phase(const Params& p, int l, int set, char* lds) {
  char* wta = WS(p) + OFF_WTA;
  const int total = (set == 0) ? 1680 : 2048;
  for (int t = BID(); t < total; t += gridDim.x) {
    int tt = t;
    const float* src; int K, N; u16* dst;
    if (set == 0) {
      if (tt < 1120) { src = p.w_in + (size_t)l * 1024 * 4480; K = 1024; N = 4480; dst = (u16*)(wta + WO_IN); }
      else if ((tt -= 1120) < 128) { src = p.w_fourier_up + (size_t)l * 512 * 1024; K = 512; N = 1024; dst = (u16*)(wta + WO_FU); }
      else if ((tt -= 128) < 128) { src = p.w_rwkv_up + (size_t)l * 512 * 1024; K = 512; N = 1024; dst = (u16*)(wta + WO_RU); }
      else if ((tt -= 128) < 256) { src = p.w_out + (size_t)l * 1024 * 1024; K = 1024; N = 1024; dst = (u16*)(wta + WO_OUT); }
      else if ((tt -= 256) < 16) { const int d = tt >> 3; tt &= 7; src = p.w_up + (size_t)(l * 2 + d) * 64 * 512; K = 64; N = 512; dst = (u16*)(wta + WO_WUP) + d * 512 * 64; }
      else if ((tt -= 16) < 16) { const int d = tt >> 3; tt &= 7; src = p.a_up + (size_t)(l * 2 + d) * 64 * 512; K = 64; N = 512; dst = (u16*)(wta + WO_AUP) + d * 512 * 64; }
      else { tt -= 16; src = p.g_up + (size_t)l * 128 * 512; K = 128; N = 512; dst = (u16*)(wta + WO_GUP); }
    } else {
      if (tt < 1024) { src = p.mlp_w1 + (size_t)l * 1024 * 4096; K = 1024; N = 4096; dst = (u16*)(WS(p) + OFF_W1T); }
      else { tt -= 1024; src = p.mlp_w2 + (size_t)l * 4096 * 1024; K = 4096; N = 1024; dst = (u16*)(WS(p) + OFF_W2T); }
    }
    convT_tile(src, K, N, dst, tt, lds);
  }
}

__device__ void dftm_gen(const Params& p) {
  u16* DM = (u16*)(WS(p) + OFF_AR);
  const size_t gt = (size_t)BID() * NTHREADS + TID(), gs = (size_t)gridDim.x * NTHREADS;
  const float TWO_PI = 6.283185307179586f;
  for (size_t i = gt; i < (size_t)2048 * 2048; i += gs) {
    int k = (int)(i >> 11), l = (int)(i & 2047);
    int m = (k * l) & 2047;
    float s, c;
    sincosf(TWO_PI * (float)m * (1.f / 2048.f), &s, &c);
    DM[DM_C + i] = f2bf(c);
    DM[DM_NS + i] = f2bf(-s);
  }
  for (size_t i = gt; i < (size_t)256 * 256; i += gs) {
    int k = (int)(i >> 8), l = (int)(i & 255);
    int m = (k * l) & 255;
    float s, c;
    sincosf(TWO_PI * (float)m * (1.f / 256.f), &s, &c);
    DM[DM_CC + i] = f2bf(c);
    DM[DM_NSC + i] = f2bf(-s);
  }
  for (size_t i = gt; i < (size_t)256 * 128; i += gs) {
    int row = (int)(i >> 7), cch = (int)(i & 127);
    int j = row & 127;
    int m = (j * cch) & 127;
    float s, c;
    sincosf(TWO_PI * (float)m * (1.f / 128.f), &s, &c);
    DM[DM_TW + i] = f2bf(row < 128 ? c : s);
  }
}

__device__ void normmod_phase(const Params& p, int l, int which, int ntok, u16* __restrict__ H) {
  const float* MOD = (const float*)(WS(p) + OFF_MOD);
  const float* XC = (const float*)(WS(p) + OFF_XC);
  const float* nw = (which == 0 ? p.norm1 : p.norm2) + l * 1024;
  const int lane = TID() & 63;
  const int gw = BID() * 8 + (TID() >> 6), nw_ = gridDim.x * 8;
  for (int t = gw; t < ntok; t += nw_) {
    const float* xr = (t < TL) ? (p.out + (size_t)t * 1024) : (XC + (size_t)(t - TL) * 1024);
    const int mrow = (t < TL) ? (t >> 11) : 8;
    const float* mo = MOD + ((size_t)l * 9 + mrow) * 6144 + which * 3072;
    float4 v[4];
    float ss = 0.f;
#pragma unroll
    for (int j = 0; j < 4; ++j) {
      v[j] = *(const float4*)(xr + j * 256 + lane * 4);
      ss += v[j].x * v[j].x + v[j].y * v[j].y + v[j].z * v[j].z + v[j].w * v[j].w;
    }
    ss = wave_sum(ss);
    const float inv = rsqrtf(ss * (1.f / 1024.f) + 1e-6f);
#pragma unroll
    for (int j = 0; j < 4; ++j) {
      const int c0 = j * 256 + lane * 4;
      float4 g = *(const float4*)(nw + c0);
      float4 sh = *(const float4*)(mo + c0);
      float4 sc = *(const float4*)(mo + 1024 + c0);
      ushort4 o;
      o.x = f2bf(v[j].x * inv * g.x * (1.f + sc.x) + sh.x);
      o.y = f2bf(v[j].y * inv * g.y * (1.f + sc.y) + sh.y);
      o.z = f2bf(v[j].z * inv * g.z * (1.f + sc.z) + sh.z);
      o.w = f2bf(v[j].w * inv * g.w * (1.f + sc.w) + sh.w);
      *(ushort4*)(H + (size_t)t * 1024 + c0) = o;
    }
  }
}

__device__ void final_norm(const Params& p) {
  const int lane = TID() & 63;
  const int gw = BID() * 8 + (TID() >> 6), nw_ = gridDim.x * 8;
  for (int t = gw; t < TL; t += nw_) {
    float* xr = p.out + (size_t)t * 1024;
    float4 v[4];
    float ss = 0.f;
#pragma unroll
    for (int j = 0; j < 4; ++j) {
      v[j] = *(const float4*)(xr + j * 256 + lane * 4);
      ss += v[j].x * v[j].x + v[j].y * v[j].y + v[j].z * v[j].z + v[j].w * v[j].w;
    }
    ss = wave_sum(ss);
    const float inv = rsqrtf(ss * (1.f / 1024.f) + 1e-6f);
#pragma unroll
    for (int j = 0; j < 4; ++j) {
      const int c0 = j * 256 + lane * 4;
      float4 g = *(const float4*)(p.norm_f + c0);
      float4 o;
      o.x = v[j].x * inv * g.x; o.y = v[j].y * inv * g.y; o.z = v[j].z * inv * g.z; o.w = v[j].w * inv * g.w;
      *(float4*)(xr + c0) = o;
    }
  }
}

__device__ void prep3a_phase(const Params& p, int l) {
  const f16* RW = (const f16*)(WS(p) + OFF_RW);
  f16* Rb = (f16*)(WS(p) + OFF_R);
  f16* Kb = (f16*)(WS(p) + OFF_K);
  f16* Vb = (f16*)(WS(p) + OFF_V);
  u16* LORA = (u16*)(WS(p) + OFF_LORA);
  u16* GDS = (u16*)(WS(p) + OFF_GDS);
  float* INVN = (float*)(WS(p) + OFF_INVN);
  const float* mu = p.mu_shift + (size_t)l * 1920;
  const float* kk_w = p.k_k + (size_t)l * 512;
  const int lane = TID() & 63;
  const int gw = BID() * 8 + (TID() >> 6), nw_ = gridDim.x * 8;
  for (int t = gw; t < TA; t += nw_) {
    const bool lat = t < TL;
    int pos, row = 0, colg = 0;
    if (lat) { pos = t & 2047; row = pos >> 6; colg = pos & 63; } else { pos = (t - TL) & 255; }
#pragma unroll
    for (int it = 0; it < 4; ++it) {
      const int chunk = it * 64 + lane;
      if (chunk < 240) {
        const int c0 = chunk * 8;
        int nb = -1;
        if (lat) {
          const int q = c0 / 480;
          if (q == 0) { if (colg > 0) nb = t - 1; }
          else if (q == 1) { if (colg < 63) nb = t + 1; }
          else if (q == 2) { if (row > 0) nb = t - 64; }
          else { if (row < 31) nb = t + 64; }
        } else {
          if (c0 < 960) { if (pos > 0) nb = t - 1; }
          else { if (pos < 255) nb = t + 1; }
        }
        f16x8 raw = *(const f16x8*)(RW + (size_t)t * 1920 + c0);
        f16x8 nbv;
        if (nb >= 0) nbv = *(const f16x8*)(RW + (size_t)nb * 1920 + c0);
        else {
#pragma unroll
          for (int j = 0; j < 8; ++j) nbv[j] = (f16)0.f;
        }
        float4 m0 = *(const float4*)(mu + c0), m1 = *(const float4*)(mu + c0 + 4);
        float mm[8] = {m0.x, m0.y, m0.z, m0.w, m1.x, m1.y, m1.z, m1.w};
        float s[8];
#pragma unroll
        for (int j = 0; j < 8; ++j) {
          float a = (float)raw[j], b = (float)nbv[j];
          s[j] = a + mm[j] * (b - a);
        }
        if (it < 3) {
          f16x8 o;
#pragma unroll
          for (int j = 0; j < 8; ++j) o[j] = f2h(s[j]);
          f16* dst = (it == 0) ? Rb : ((it == 1) ? Kb : Vb);
          *(f16x8*)(dst + (size_t)t * 512 + (c0 - it * 512)) = o;
          if (it == 1) {
            const int cc = c0 - 512;
            float4 k0 = *(const float4*)(kk_w + cc), k1 = *(const float4*)(kk_w + cc + 4);
            float kw[8] = {k0.x, k0.y, k0.z, k0.w, k1.x, k1.y, k1.z, k1.w};
            float ss = 0.f;
#pragma unroll
            for (int j = 0; j < 8; ++j) { float q = (float)o[j] * kw[j]; ss += q * q; }
            ss = red8(ss);
            if ((lane & 7) == 0) INVN[(size_t)t * 8 + (lane >> 3)] = 1.f / fmaxf(sqrtf(ss), 1e-12f);
          }
        } else if (c0 < 1792) {
          u16x8 o;
          const bool th = c0 < 1664;
#pragma unroll
          for (int j = 0; j < 8; ++j) o[j] = f2bf(th ? tanhf(s[j]) : s[j]);
          *(u16x8*)(LORA + (size_t)t * 256 + (c0 - 1536)) = o;
        } else {
          u16x8 o;
#pragma unroll
          for (int j = 0; j < 8; ++j) o[j] = f2bf(sigmoidf_(s[j]));
          *(u16x8*)(GDS + (size_t)t * 128 + (c0 - 1792)) = o;
        }
      }
    }
  }
}

__device__ void post5a_phase(const Params& p, int l, int ntok) {
  const f16* Rb = (const f16*)(WS(p) + OFF_R);
  const f16* Kb = (const f16*)(WS(p) + OFF_K);
  const f16* Vb = (const f16*)(WS(p) + OFF_V);
  const f16* A0 = (const f16*)(WS(p) + OFF_AR);
  const f16* A1 = A0 + (size_t)TA * 512;
  f16* Y0 = (f16*)(WS(p) + OFF_YS0);
  const f16* Y1 = (const f16*)(WS(p) + OFF_YS1);
  const int lane = TID() & 63;
  const int c0 = lane * 8;
  float ka[8], rk[8], lw[8], lb[8];
#pragma unroll
  for (int j = 0; j < 8; ++j) {
    ka[j] = p.k_a[l * 512 + c0 + j];
    rk[j] = p.r_k[l * 512 + c0 + j];
    lw[j] = p.ln_x_w[l * 512 + c0 + j];
    lb[j] = p.ln_x_b[l * 512 + c0 + j];
  }
  const int gw = BID() * 8 + (TID() >> 6), nw_ = gridDim.x * 8;
  for (int t = gw; t < ntok; t += nw_) {
    const size_t o = (size_t)t * 512 + c0;
    f16x8 r = *(const f16x8*)(Rb + o), k = *(const f16x8*)(Kb + o), v = *(const f16x8*)(Vb + o);
    f16x8 a0 = *(const f16x8*)(A0 + o), a1 = *(const f16x8*)(A1 + o);
    f16x8 y0 = *(const f16x8*)(Y0 + o), y1 = *(const f16x8*)(Y1 + o);
    float y[8], bs = 0.f, sum = 0.f;
#pragma unroll
    for (int j = 0; j < 8; ++j) {
      float kf = (float)k[j];
      float kd0 = kf * (1.f + ((float)a0[j] - 1.f) * ka[j]);
      float kd1 = kf * (1.f + ((float)a1[j] - 1.f) * ka[j]);
      bs += (float)r[j] * (kd0 + kd1) * rk[j];
      y[j] = (float)y0[j] + (float)y1[j];
      sum += y[j];
    }
    bs = red8(bs);
    sum = red8(sum);
    const float mean = sum * (1.f / 64.f);
    float vs = 0.f;
#pragma unroll
    for (int j = 0; j < 8; ++j) { float d = y[j] - mean; vs += d * d; }
    vs = red8(vs);
    const float rstd = rsqrtf(vs * (1.f / 64.f) + 64e-5f);
    u16x8 z;
#pragma unroll
    for (int j = 0; j < 8; ++j) {
      float yn = (y[j] - mean) * rstd * lw[j] + lb[j];
      z[j] = f2bf(yn + bs * (float)v[j]);
    }
    *(u16x8*)((u16*)Y0 + o) = z;
  }
}

constexpr int TB = 32;
constexpr int NBLK = 2304 / TB;
constexpr int ST_VEC = TB * 320;
constexpr int ST_FLOATS = ST_VEC + TB * 32 * 2;

__device__ __forceinline__ int scan_token(int d, int b, int s) {
  if (s < 256) return TL + b * 256 + (d == 0 ? s : 255 - s);
  const int s2 = s - 256;
  return b * 2048 + (d == 0 ? s2 : 2047 - s2);
}

__device__ __forceinline__ float red16(float x) {
  x += dpp_f<0xB1>(x);
  x += dpp_f<0x4E>(x);
  x += dpp_f<0x141>(x);
  x += dpp_f<0x140>(x);
  return x;
}

__device__ void scan_phase(const Params& p, int l, char* lds) {
  float* st = (float*)lds;
  const f16* Rb = (const f16*)(WS(p) + OFF_R);
  const f16* Kb = (const f16*)(WS(p) + OFF_K);
  const f16* Vb = (const f16*)(WS(p) + OFF_V);
  const float* INVN = (const float*)(WS(p) + OFF_INVN);
  const int tid = TID();
  const int lane = tid & 63, wave = tid >> 6;
  for (int item = BID(); item < 256; item += gridDim.x) {
    const int chain = item >> 1, half = item & 1;
    const int d = chain >> 6, b = (chain >> 3) & 7, h = chain & 7;
    const f16* Eb = (const f16*)(WS(p) + OFF_EH) + (size_t)d * TA * 512;
    const f16* Ab = (const f16*)(WS(p) + OFF_AR) + (size_t)d * TA * 512;
    f16* Yb = (f16*)(WS(p) + (d == 0 ? OFF_YS0 : OFF_YS1));
    const int lstep = tid >> 4, lkq = tid & 15;
    const int cb = h * 64 + lkq * 4;
    const float4 kkw = *(const float4*)(p.k_k + l * 512 + cb);
    const float4 kaw = *(const float4*)(p.k_a + l * 512 + cb);
    const int vcol = h * 64 + half * 32 + lkq * 2;
    const int rl = wave * 4 + (lane >> 4), kq = lane & 15;
    f32x2 SA = f32x2{0.f, 0.f}, SB = f32x2{0.f, 0.f};
    f16x4 kv, rv, ev, av;
    __attribute__((ext_vector_type(2))) _Float16 vv2;
    float invn;
    auto issue = [&](int blk) {
      const int tok = scan_token(d, b, blk * TB + lstep);
      const size_t o = (size_t)tok * 512 + cb;
      kv = *(const f16x4*)(Kb + o); rv = *(const f16x4*)(Rb + o);
      ev = *(const f16x4*)(Eb + o); av = *(const f16x4*)(Ab + o);
      vv2 = *(const __attribute__((ext_vector_type(2))) _Float16*)(Vb + (size_t)tok * 512 + vcol);
      invn = INVN[(size_t)tok * 8 + h];
    };
    auto commit = [&](int blk) {
      float* sg = st + (blk & 1) * ST_FLOATS;
      const float k0 = (float)kv[0], k1 = (float)kv[1], k2 = (float)kv[2], k3 = (float)kv[3];
      const float a0 = (float)av[0], a1 = (float)av[1], a2 = (float)av[2], a3 = (float)av[3];
      const float q0 = k0 * kkw.x * invn, q1 = k1 * kkw.y * invn, q2 = k2 * kkw.z * invn, q3 = k3 * kkw.w * invn;
      float* base = sg + lstep * 320 + lkq * 4;
      *(float4*)(base + 0) = float4{__expf(-(float)ev[0]), __expf(-(float)ev[1]), __expf(-(float)ev[2]), __expf(-(float)ev[3])};
      *(float4*)(base + 64) = float4{q0, q1, q2, q3};
      *(float4*)(base + 128) = float4{q0 * a0, q1 * a1, q2 * a2, q3 * a3};
      *(float4*)(base + 192) = float4{k0 * (1.f + (a0 - 1.f) * kaw.x), k1 * (1.f + (a1 - 1.f) * kaw.y),
                                      k2 * (1.f + (a2 - 1.f) * kaw.z), k3 * (1.f + (a3 - 1.f) * kaw.w)};
      *(float4*)(base + 256) = float4{(float)rv[0], (float)rv[1], (float)rv[2], (float)rv[3]};
      *(float2*)(sg + ST_VEC + lstep * 32 + lkq * 2) = float2{(float)vv2[0], (float)vv2[1]};
    };
    auto store_y = [&](int blk) {
      const float* sg = st + (blk & 1) * ST_FLOATS;
      const int tok = scan_token(d, b, blk * TB + lstep);
      const float2 yv = *(const float2*)(sg + ST_VEC + TB * 32 + lstep * 32 + lkq * 2);
      __attribute__((ext_vector_type(2))) _Float16 o;
      o[0] = f2h(yv.x); o[1] = f2h(yv.y);
      *(__attribute__((ext_vector_type(2))) _Float16*)(Yb + (size_t)tok * 512 + vcol) = o;
    };
    __syncthreads();
    issue(0);
    commit(0);
    __syncthreads();
    for (int blk = 0; blk < NBLK; ++blk) {
      const bool more = blk + 1 < NBLK;
      if (more) issue(blk + 1);
      {
        float* sg = st + (blk & 1) * ST_FLOATS;
        const float* vb = sg + ST_VEC;
        float* yb = sg + ST_VEC + TB * 32;
        float ysel0 = 0.f, ysel1 = 0.f;
        const float* base0 = sg + kq * 4;
        f32x4 w4 = *(const f32x4*)(base0 + 0);
        f32x4 q4 = *(const f32x4*)(base0 + 64);
        f32x4 a4 = *(const f32x4*)(base0 + 128);
        f32x4 d4 = *(const f32x4*)(base0 + 192);
        f32x4 r4 = *(const f32x4*)(base0 + 256);
        float vv = vb[rl];
#pragma unroll
        for (int u = 0; u < TB; ++u) {
          f32x4 nw4, nq4, na4, nd4, nr4;
          float nvv;
          if (u + 1 < TB) {
            const float* nb = base0 + (u + 1) * 320;
            nw4 = *(const f32x4*)(nb + 0);
            nq4 = *(const f32x4*)(nb + 64);
            na4 = *(const f32x4*)(nb + 128);
            nd4 = *(const f32x4*)(nb + 192);
            nr4 = *(const f32x4*)(nb + 256);
            nvv = vb[(u + 1) * 32 + rl];
          }
          const f32x2 vv2 = f32x2{vv, vv};
          f32x2 pp = SA * q4.xy;
          pp = __builtin_elementwise_fma(SB, q4.zw, pp);
          const float sa = red16(pp.x + pp.y);
          const f32x2 nsa = f32x2{-sa, -sa};
          f32x2 tA = SA * w4.xy;
          f32x2 tB = SB * w4.zw;
          tA = __builtin_elementwise_fma(vv2, d4.xy, tA);
          tB = __builtin_elementwise_fma(vv2, d4.zw, tB);
          SA = __builtin_elementwise_fma(nsa, a4.xy, tA);
          SB = __builtin_elementwise_fma(nsa, a4.zw, tB);
          f32x2 yy = SA * r4.xy;
          yy = __builtin_elementwise_fma(SB, r4.zw, yy);
          const float y = red16(yy.x + yy.y);
          if (u < 16) ysel0 = (u == kq) ? y : ysel0;
          else ysel1 = ((u - 16) == kq) ? y : ysel1;
          if (u + 1 < TB) { w4 = nw4; q4 = nq4; a4 = na4; d4 = nd4; r4 = nr4; vv = nvv; }
        }
        yb[kq * 32 + rl] = ysel0;
        yb[(16 + kq) * 32 + rl] = ysel1;
      }
      if (more) commit(blk + 1);
      __syncthreads();
      store_y(blk);
    }
  }
}

__device__ void proj_phase(const Params& p, char* lds) {
  const u16* H = (const u16*)(WS(p) + OFF_EH);
  const u16* WinT = (const u16*)(WS(p) + OFF_WTA + WO_IN);
  u16* FIN = (u16*)(WS(p) + OFF_FIN);
  f16* RW = (f16*)(WS(p) + OFF_RW);
  constexpr int MT = TA / 256, NT = 19;
  for (int tile = BID(); tile < MT * NT; tile += gridDim.x) {
    const int mt = tile / NT, nt = tile % NT;
    f32x4 acc[4][4];
    acc_zero(acc);
    gemm_loop(acc, H + (size_t)mt * 256 * 1024, 1024, WinT + (size_t)nt * 128 * 1024, 1024, 1024, lds);
    const int m0 = mt * 256, n0 = nt * 128;
    if (n0 < 512) {
      epi_apply(acc, lds, [&](int r, int c, float (&v)[8]) { *(u16x8*)(FIN + (size_t)(m0 + r) * 512 + n0 + c) = pack_bf8(v); });
    } else {
      epi_apply(acc, lds, [&](int r, int c, float (&v)[8]) { *(f16x8*)(RW + (size_t)(m0 + r) * 1920 + (n0 - 512) + c) = pack_h8(v); });
    }
  }
}

__device__ void dft1_phase(const Params& p, int l, char* lds) {
  const u16* FIN = (const u16*)(WS(p) + OFF_FIN);
  const u16* TW = (const u16*)(WS(p) + OFF_AR) + DM_TW;
  u16* UCS = (u16*)(WS(p) + OFF_EH);
  u16* UCSC = UCS + (size_t)32 * 256 * 2048;
  const int ntiles = 512 + (l == 0 ? 64 : 0);
  for (int tile = BID(); tile < ntiles; tile += gridDim.x) {
    const u16* bt;
    u16* o;
    int ldo;
    if (tile < 512) {
      const int bg = tile >> 4, nt = tile & 15, b = bg >> 2, g = bg & 3;
      bt = FIN + (size_t)(b * 2048 + nt * 128) * 512 + g * 128;
      o = UCS + (size_t)bg * 256 * 2048 + nt * 128;
      ldo = 2048;
    } else {
      const int t2 = tile - 512;
      const int bg = t2 >> 1, nt = t2 & 1, b = bg >> 2, g = bg & 3;
      bt = FIN + (size_t)(TL + b * 256 + nt * 128) * 512 + g * 128;
      o = UCSC + (size_t)bg * 256 * 256 + nt * 128;
      ldo = 256;
    }
    f32x4 acc[4][4];
    acc_zero(acc);
    gemm_loop(acc, TW, 128, bt, 512, 128, lds);
    epi_apply(acc, lds, [&](int r, int c, float (&v)[8]) { *(u16x8*)(o + (size_t)r * ldo + c) = pack_bf8(v); });
  }
}

__device__ void dft2_phase(const Params& p, int l, char* lds) {
  const u16* DM = (const u16*)(WS(p) + OFF_AR);
  const u16* UCS = (const u16*)(WS(p) + OFF_EH);
  const u16* UCSC = UCS + (size_t)32 * 256 * 2048;
  u16* FOUT = (u16*)(WS(p) + OFF_FIN);
  const int ntiles = 256 + (l == 0 ? 32 : 0);
  for (int tile = BID(); tile < ntiles; tile += gridDim.x) {
    const u16 *a0, *a1, *bt;
    u16* o;
    int Ld;
    float sc;
    if (tile < 256) {
      const int b = tile >> 5, mt = (tile >> 2) & 7, g = tile & 3;
      Ld = 2048;
      bt = UCS + (size_t)((b * 4 + g) * 256) * 2048;
      a0 = DM + DM_C + (size_t)mt * 256 * 2048;
      a1 = DM + DM_NS + (size_t)mt * 256 * 2048;
      o = FOUT + (size_t)(b * 2048 + mt * 256) * 512 + g * 128;
      sc = 1.f / 512.f;
    } else {
      const int t2 = tile - 256;
      const int b = t2 >> 2, g = t2 & 3;
      Ld = 256;
      bt = UCSC + (size_t)((b * 4 + g) * 256) * 256;
      a0 = DM + DM_CC;
      a1 = DM + DM_NSC;
      o = FOUT + (size_t)(TL + b * 256) * 512 + g * 128;
      sc = 0.005524271728019903f;
    }
    f32x4 acc[4][4];
    acc_zero(acc);
#pragma unroll 1
    for (int seg = 0; seg < 2; ++seg)
      gemm_loop(acc, seg == 0 ? a0 : a1, Ld, bt + (size_t)seg * 128 * Ld, Ld, Ld, lds);
    epi_apply(acc, lds, [&](int r, int c, float (&v)[8]) {
#pragma unroll
      for (int j = 0; j < 8; ++j) v[j] *= sc;
      *(u16x8*)(o + (size_t)r * 512 + c) = pack_bf8(v);
    });
  }
}

__device__ void lora_phase(const Params& p, int l, char* lds) {
  const u16* LORA = (const u16*)(WS(p) + OFF_LORA);
  const u16* WupT = (const u16*)(WS(p) + OFF_WTA + WO_WUP);
  const u16* AupT = (const u16*)(WS(p) + OFF_WTA + WO_AUP);
  constexpr int MT = TA / 256;
  for (int tile = BID(); tile < 4 * MT * 4; tile += gridDim.x) {
    const int which = tile / (MT * 4), rem = tile % (MT * 4), mt = rem >> 2, nt = rem & 3;
    const int d = which & 1;
    f32x4 acc[4][4];
    acc_zero(acc);
    const u16* bt = (which < 2 ? WupT : AupT) + (size_t)d * 512 * 64 + (size_t)nt * 128 * 64;
    gemm_loop(acc, LORA + (size_t)mt * 256 * 256 + which * 64, 256, bt, 64, 64, lds);
    f16* o = (f16*)(WS(p) + (which < 2 ? OFF_EH : OFF_AR)) + (size_t)d * TA * 512 + (size_t)mt * 256 * 512 + nt * 128;
    const float* bias = (which < 2 ? p.w0 : p.a0) + (size_t)l * 1024 + d * 512 + nt * 128;
    const float mul = (which < 2) ? 0.6065306597126334f : 1.f;
    epi_apply(acc, lds, [&](int r, int c, float (&v)[8]) {
      const float4 b0 = *(const float4*)(bias + c), b1 = *(const float4*)(bias + c + 4);
      const float bb[8] = {b0.x, b0.y, b0.z, b0.w, b1.x, b1.y, b1.z, b1.w};
#pragma unroll
      for (int j = 0; j < 8; ++j) v[j] = sigmoidf_(bb[j] + v[j]) * mul;
      *(f16x8*)(o + (size_t)r * 512 + c) = pack_h8(v);
    });
  }
}

__device__ void g_phase(const Params& p, int ntok, char* lds) {
  const u16* GDS = (const u16*)(WS(p) + OFF_GDS);
  const u16* GupT = (const u16*)(WS(p) + OFF_WTA + WO_GUP);
  u16* Z = (u16*)(WS(p) + OFF_YS0);
  const int MT = ntok / 256;
  for (int tile = BID(); tile < MT * 4; tile += gridDim.x) {
    const int mt = tile >> 2, nt = tile & 3;
    f32x4 acc[4][4];
    acc_zero(acc);
    gemm_loop(acc, GDS + (size_t)mt * 256 * 128, 128, GupT + (size_t)nt * 128 * 128, 128, 128, lds);
    u16* o = Z + (size_t)mt * 256 * 512 + nt * 128;
    epi_apply(acc, lds, [&](int r, int c, float (&v)[8]) {
      u16x8* q = (u16x8*)(o + (size_t)r * 512 + c);
      const u16x8 z = *q;
#pragma unroll
      for (int j = 0; j < 8; ++j) v[j] *= bf2f(z[j]);
      *q = pack_bf8(v);
    });
  }
}

__device__ void merge_phase(const Params& p, int ntok, char* lds) {
  const u16* H = (const u16*)(WS(p) + OFF_EH);
  const u16* WinT = (const u16*)(WS(p) + OFF_WTA + WO_IN);
  const u16* FOUT = (const u16*)(WS(p) + OFF_FIN);
  const u16* Z = (const u16*)(WS(p) + OFF_YS0);
  const u16* WfuT = (const u16*)(WS(p) + OFF_WTA + WO_FU);
  const u16* WruT = (const u16*)(WS(p) + OFF_WTA + WO_RU);
  u16* MG = (u16*)(WS(p) + OFF_AR);
  u16* SG = (u16*)(WS(p) + OFF_YS1);
  const int MT = ntok / 256;
  for (int tile = BID(); tile < MT * 8; tile += gridDim.x) {
    const int mt = tile >> 3, nt = tile & 7;
    u16* o = MG + (size_t)mt * 256 * 1024 + nt * 128;
    u16* sg = SG + (size_t)mt * 256 * 1024 + nt * 128;
#pragma unroll 1
    for (int sub = 0; sub < 4; ++sub) {
      const int pass = sub >> 1;
      const bool gate = (sub & 1) == 0;
      const u16* A = gate ? (H + (size_t)mt * 256 * 1024) : ((pass == 0 ? FOUT : Z) + (size_t)mt * 256 * 512);
      const u16* Bt = gate ? (WinT + (size_t)(2432 + pass * 1024 + nt * 128) * 1024)
                           : ((pass == 0 ? WfuT : WruT) + (size_t)nt * 128 * 512);
      const int K = gate ? 1024 : 512;
      f32x4 acc[4][4];
      acc_zero(acc);
      gemm_loop(acc, A, K, Bt, K, K, lds);
      epi_apply(acc, lds, [&](int r, int c, float (&v)[8]) {
        u16x8* qs = (u16x8*)(sg + (size_t)r * 1024 + c);
        u16x8* qo = (u16x8*)(o + (size_t)r * 1024 + c);
        if (gate) {
#pragma unroll
          for (int j = 0; j < 8; ++j) v[j] = sigmoidf_(v[j]);
          *qs = pack_bf8(v);
        } else {
          const u16x8 sv = *qs;
#pragma unroll
          for (int j = 0; j < 8; ++j) v[j] *= bf2f(sv[j]);
          if (pass == 1) {
            const u16x8 ov = *qo;
#pragma unroll
            for (int j = 0; j < 8; ++j) v[j] += bf2f(ov[j]);
          }
          *qo = pack_bf8(v);
        }
      });
    }
  }
}

__device__ void resid_gemm_phase(const Params& p, int l, int ntok, const u16* A, int K, const u16* Bt, int gate_off, char* lds) {
  const float* MOD = (const float*)(WS(p) + OFF_MOD);
  float* XC = (float*)(WS(p) + OFF_XC);
  const int MT = ntok / 256;
  for (int tile = BID(); tile < MT * 8; tile += gridDim.x) {
    const int mt = tile >> 3, nt = tile & 7;
    f32x4 acc[4][4];
    acc_zero(acc);
    gemm_loop(acc, A + (size_t)mt * 256 * K, K, Bt + (size_t)nt * 128 * K, K, K, lds);
    const int m0 = mt * 256, n0 = nt * 128;
    epi_apply(acc, lds, [&](int r, int c, float (&v)[8]) {
      const int row = m0 + r, col = n0 + c;
      float* q = (row < TL) ? (p.out + (size_t)row * 1024 + col) : (XC + (size_t)(row - TL) * 1024 + col);
      const float* gp = MOD + ((size_t)l * 9 + ((row < TL) ? (row >> 11) : 8)) * 6144 + gate_off + col;
      const float4 g0 = *(const float4*)gp, g1 = *(const float4*)(gp + 4);
      float4 x0 = *(const float4*)q, x1 = *(const float4*)(q + 4);
      x0.x += g0.x * v[0]; x0.y += g0.y * v[1]; x0.z += g0.z * v[2]; x0.w += g0.w * v[3];
      x1.x += g1.x * v[4]; x1.y += g1.y * v[5]; x1.z += g1.z * v[6]; x1.w += g1.w * v[7];
      *(float4*)q = x0; *(float4*)(q + 4) = x1;
    });
  }
}

__device__ void mlp_up_phase(const Params& p, int ntok, char* lds) {
  const u16* H2 = (const u16*)(WS(p) + OFF_EH);
  const u16* W1T = (const u16*)(WS(p) + OFF_W1T);
  u16* HID = (u16*)(WS(p) + OFF_HID);
  const int MT = ntok / 256;
  for (int tile = BID(); tile < MT * 32; tile += gridDim.x) {
    const int mt = tile >> 5, nt = tile & 31;
    f32x4 acc[4][4];
    acc_zero(acc);
    gemm_loop(acc, H2 + (size_t)mt * 256 * 1024, 1024, W1T + (size_t)nt * 128 * 1024, 1024, 1024, lds);
    u16* o = HID + (size_t)mt * 256 * 4096 + nt * 128;
    epi_apply(acc, lds, [&](int r, int c, float (&v)[8]) {
#pragma unroll
      for (int j = 0; j < 8; ++j) { const float t = fmaxf(v[j], 0.f); v[j] = t * t; }
      *(u16x8*)(o + (size_t)r * 4096 + c) = pack_bf8(v);
    });
  }
}

#define XB_TMO      128
#define XB_XCNT(j)  (256  + 64 * (j))
#define XB_XSUB(j)  (1280 + 64 * (j))
#define XB_XGEN(j)  (2304 + 64 * (j))
#define XB_TOP      3328
#define XB_TOPGEN   3392
#define XCD_BAR_WORDS 3456
#define XB_SPIN_CAP (1u << 18)
#define LAS __attribute__((address_space(3)))

__device__ __forceinline__ unsigned xb_ld(unsigned* p)              { return __hip_atomic_load(p, __ATOMIC_RELAXED, __HIP_MEMORY_SCOPE_AGENT); }
__device__ __forceinline__ unsigned xb_add(unsigned* p, unsigned v) { return __hip_atomic_fetch_add(p, v, __ATOMIC_RELAXED, __HIP_MEMORY_SCOPE_AGENT); }
__device__ __forceinline__ unsigned xb_xcc_id() { return (unsigned)__builtin_amdgcn_s_getreg((3 << 11) | 20) & 0xFu; }
#define XB_SPIN(cond, bar) do { unsigned _sp = 0; while (cond) { __builtin_amdgcn_s_sleep(1); \
    if ((++_sp & 255u) == 0u) { if (xb_ld(&(bar)[XB_TMO])) break; if (_sp > XB_SPIN_CAP) { atomicAdd(&(bar)[XB_TMO], 1u); break; } } } } while (0)

struct XcdBarrier { unsigned* bar; unsigned x; volatile LAS unsigned* st; };

__device__ __forceinline__ XcdBarrier xcd_barrier_post(unsigned* bar, volatile LAS unsigned* st) {
    XcdBarrier b; b.bar = bar; b.x = xb_xcc_id(); b.st = st;
    if (threadIdx.x == 0) (void)xb_add(&bar[XB_XCNT(b.x)], 1u);
    return b;
}
__device__ __forceinline__ void xcd_barrier_complete(unsigned* bar, unsigned x, unsigned& nloc, unsigned& nx) {
    const unsigned G = gridDim.x * gridDim.y * gridDim.z;
    unsigned sum, cnt, mine, sp = 0u;
    for (;;) {
        sum = 0u; cnt = 0u; mine = 0u;
#pragma unroll
        for (unsigned j = 0; j < 16; ++j) { const unsigned c = xb_ld(&bar[XB_XCNT(j)]); sum += c; cnt += (c > 0u) ? 1u : 0u; mine = (j == x) ? c : mine; }
        if (sum == G) break;
        __builtin_amdgcn_s_sleep(1);
        if ((++sp & 255u) == 0u) { if (xb_ld(&bar[XB_TMO])) break; if (sp > XB_SPIN_CAP) { atomicAdd(&bar[XB_TMO], 1u); break; } }
    }
    nloc = mine > 0u ? mine : 1u; nx = cnt > 0u ? cnt : 1u;
}
__device__ __forceinline__ void xcd_barrier(const XcdBarrier& b) {
    asm volatile("s_waitcnt vmcnt(0)" ::: "memory");
    __syncthreads();
    if (threadIdx.x == 0) {
        unsigned* bar = b.bar;
        __builtin_amdgcn_s_waitcnt(0);
        unsigned nloc = b.st[0], nx = b.st[1];
        if (nloc == 0u) { xcd_barrier_complete(bar, b.x, nloc, nx); b.st[0] = nloc; b.st[1] = nx; }
        const unsigned old = xb_add(&bar[XB_XSUB(b.x)], 1u);
        const unsigned gen = old / nloc;
        if (old + 1u == (gen + 1u) * nloc) {
            __builtin_amdgcn_fence(__ATOMIC_RELEASE, "agent");
            asm volatile("s_waitcnt vmcnt(0)" ::: "memory");
            const unsigned og = xb_add(&bar[XB_TOP], 1u);
            const unsigned tg = og / nx;
            if (og + 1u == (tg + 1u) * nx) xb_add(&bar[XB_TOPGEN], 1u);
            else XB_SPIN(xb_ld(&bar[XB_TOPGEN]) == tg, bar);
            __builtin_amdgcn_fence(__ATOMIC_ACQUIRE, "agent");
            xb_add(&bar[XB_XGEN(b.x)], 1u);
            asm volatile("s_waitcnt vmcnt(0)" ::: "memory");
        } else {
            XB_SPIN(xb_ld(&bar[XB_XGEN(b.x)]) == gen, bar);
            __builtin_amdgcn_fence(__ATOMIC_ACQUIRE, "agent");
            asm volatile("s_waitcnt vmcnt(0)" ::: "memory");
        }
    }
    __syncthreads();
}

constexpr int PH_PER_LAYER = 13;
constexpr int N_PHASES = 1 + 2 * PH_PER_LAYER + 1;

__device__ void run_phase(const Params& p, int ph, char* lds) {
  if (ph == 0) {
    copy_f4(p.x, p.out, (size_t)TL * 1024 / 4);
    copy_f4(p.ctx, (float*)(WS(p) + OFF_XC), (size_t)TC * 1024 / 4);
    mod_phase(p, lds);
    return;
  }
  if (ph == N_PHASES - 1) { final_norm(p); return; }
  const int l = (ph - 1) / PH_PER_LAYER, q = (ph - 1) % PH_PER_LAYER;
  const int ntok = (l == 0) ? TA : TL;
  switch (q) {
    case 0:
      conv_phase(p, l, 0, lds);
      dftm_gen(p);
      normmod_phase(p, l, 0, TA, (u16*)(WS(p) + OFF_EH));
      break;
    case 1: proj_phase(p, lds); break;
    case 2: dft1_phase(p, l, lds); prep3a_phase(p, l); break;
    case 3: dft2_phase(p, l, lds); break;
    case 4: lora_phase(p, l, lds); break;
    case 5: scan_phase(p, l, lds); break;
    case 6:
      post5a_phase(p, l, ntok);
      normmod_phase(p, l, 0, ntok, (u16*)(WS(p) + OFF_EH));
      conv_phase(p, l, 1, lds);
      break;
    case 7: g_phase(p, ntok, lds); break;
    case 8: merge_phase(p, ntok, lds); break;
    case 9: resid_gemm_phase(p, l, ntok, (const u16*)(WS(p) + OFF_AR), 1024, (const u16*)(WS(p) + OFF_WTA + WO_OUT), 2048, lds); break;
    case 10: normmod_phase(p, l, 1, ntok, (u16*)(WS(p) + OFF_EH)); break;
    case 11: mlp_up_phase(p, ntok, lds); break;
    case 12: resid_gemm_phase(p, l, ntok, (const u16*)(WS(p) + OFF_HID), 4096, (const u16*)(WS(p) + OFF_W2T), 5120, lds); break;
  }
}

extern "C" __global__ void __launch_bounds__(NTHREADS) fwd_megakernel(Params p) {
  extern __shared__ __attribute__((aligned(16))) char lds[];
#if ONE_LAUNCH
  cg::grid_group grid = cg::this_grid();
  __shared__ uint4 xb_words;
  if (threadIdx.x == 0) xb_words = make_uint4(0u, 0u, 0u, 0u);
  __syncthreads();
  XcdBarrier xb = xcd_barrier_post((unsigned*)(p.ws + OFF_BAR), (volatile LAS unsigned*)&xb_words);
#ifndef REP_MASK
#define REP_MASK 0
#endif
  int ph = p.ph_lo, rep = 0;
  while (ph < p.ph_hi) {
    run_phase(p, ph, lds);
    const bool first = (ph == p.ph_lo) && (rep == 0);
    const bool again = (rep == 0) && ph >= 1 && ph < N_PHASES - 1 && ((REP_MASK >> ((ph - 1) % PH_PER_LAYER)) & 1);
    if (again) rep = 1; else { rep = 0; ++ph; }
    if (ph < p.ph_hi) {
      if (first) grid.sync();
      else xcd_barrier(xb);
    }
  }
#else
  for (int ph = p.ph_lo; ph < p.ph_hi; ++ph) run_phase(p, ph, lds);
#endif
}

extern "C" void kernel_launch(void* const* d_in, const int* in_sizes, int n_in, void* d_out, int out_size, void* d_ws,
                              size_t ws_size, hipStream_t stream) {
  static int grid = 0;
  if (grid == 0) {
    if (ws_size < WS_NEED) { fprintf(stderr, "kernel_launch: workspace too small: %zu < %zu\n", ws_size, (size_t)WS_NEED); grid = -1; return; }
    int dev = 0, cus = 0, per_cu = 0;
    hipGetDevice(&dev);
    hipDeviceGetAttribute(&cus, hipDeviceAttributeMultiprocessorCount, dev);
    hipFuncSetAttribute((const void*)fwd_megakernel, hipFuncAttributeMaxDynamicSharedMemorySize, LDS_BYTES);
    hipOccupancyMaxActiveBlocksPerMultiprocessor(&per_cu, (const void*)fwd_megakernel, NTHREADS, LDS_BYTES);
    if (per_cu < 1) per_cu = 1;
    grid = cus;
    (void)hipGetLastError();
  }
  if (grid < 0) return;
  Params p{};
  const float** pp = (const float**)&p;
  for (int i = 0; i < 26; ++i) pp[i] = (const float*)d_in[i];
  p.out = (float*)d_out;
  p.ws = (char*)d_ws;
#if ONE_LAUNCH
  (void)hipMemsetAsync((char*)d_ws + OFF_BAR, 0, XCD_BAR_WORDS * sizeof(unsigned), stream);
  p.ph_lo = 0; p.ph_hi = N_PHASES;
  void* args[] = {&p};
  hipError_t e = hipLaunchCooperativeKernel((const void*)fwd_megakernel, dim3(grid), dim3(NTHREADS), args, LDS_BYTES, stream);
  if (e != hipSuccess) fprintf(stderr, "cooperative launch failed: %s (grid %d)\n", hipGetErrorString(e), grid);
#else
  for (int ph = 0; ph < N_PHASES; ++ph) {
    p.ph_lo = ph; p.ph_hi = ph + 1;
    hipLaunchKernelGGL(fwd_megakernel, dim3(grid), dim3(NTHREADS), LDS_BYTES, stream, p);
  }
#endif
}
```

```cpp
#include <hip/hip_runtime.h>
#include <hip/hip_cooperative_groups.h>
#include <cstdio>
#include <cstdint>
#include <cstddef>
namespace cg = cooperative_groups;

typedef unsigned short u16;
typedef _Float16 f16;
using bf16x8 = __attribute__((ext_vector_type(8))) short;
using f32x4 = __attribute__((ext_vector_type(4))) float;
using f32x2 = __attribute__((ext_vector_type(2))) float;
using f16x8 = __attribute__((ext_vector_type(8))) _Float16;
using f16x4 = __attribute__((ext_vector_type(4))) _Float16;
using u16x8 = __attribute__((ext_vector_type(8))) unsigned short;

#ifndef ONE_LAUNCH
#define ONE_LAUNCH 1
#endif

constexpr int D = 1024, NB = 8, L = 2048, LC = 256, TL = 16384, TC = 2048, TA = 18432;
constexpr int NTHREADS = 512;
constexpr int LDT = 72;
constexpr int STAGE_ELEMS = (256 + 128) * LDT;
constexpr int LDS_STAGE_BYTES = 131072;
constexpr int LDS_BYTES = LDS_STAGE_BYTES + 16;

constexpr size_t MiB = (size_t)1 << 20;
constexpr size_t OFF_MOD = 0;
constexpr size_t OFF_XC = 1 * MiB;
constexpr size_t OFF_WTA = 9 * MiB;
constexpr size_t OFF_FIN = 23 * MiB;
constexpr size_t OFF_EH = 41 * MiB;
constexpr size_t OFF_RW = 77 * MiB;
constexpr size_t OFF_W1T = 77 * MiB;
constexpr size_t OFF_W2T = 85 * MiB;
constexpr size_t OFF_YS0 = 93 * MiB;
constexpr size_t OFF_YS1 = 111 * MiB;
constexpr size_t OFF_HID = 93 * MiB;
constexpr size_t OFF_R = 144 * MiB + MiB / 2;
constexpr size_t OFF_K = OFF_R + 18 * MiB;
constexpr size_t OFF_V = OFF_K + 18 * MiB;
constexpr size_t OFF_AR = OFF_V + 18 * MiB;
constexpr size_t OFF_LORA = OFF_AR + 36 * MiB;
constexpr size_t OFF_GDS = OFF_LORA + 9 * MiB;
constexpr size_t OFF_INVN = OFF_GDS + 4 * MiB + MiB / 2;
constexpr size_t OFF_EO = OFF_YS0;
constexpr size_t OFF_X1024 = OFF_YS0 + 16 * MiB;
constexpr size_t OFF_BAR = 250 * MiB;
constexpr size_t WS_NEED = OFF_BAR + MiB;
constexpr size_t WO_IN = 0, WO_FU = 9175040, WO_RU = 10223616, WO_OUT = 11272192, WO_WUP = 13369344, WO_AUP = 13500416, WO_GUP = 13631488;
constexpr size_t DM_C = 0, DM_NS = (size_t)2048 * 2048, DM_CC = (size_t)2 * 2048 * 2048, DM_NSC = DM_CC + 65536, DM_TW = DM_NSC + 65536;

struct Params {
  const float *x, *c, *ctx, *c_ctx, *w_mod, *b_mod, *norm1, *norm2, *w_in, *mu_shift, *w0, *w_up, *a0, *a_up, *g_up,
      *k_k, *k_a, *r_k, *ln_x_w, *ln_x_b, *w_fourier_up, *w_rwkv_up, *w_out, *mlp_w1, *mlp_w2, *norm_f;
  float* out;
  char* ws;
  int ph_lo, ph_hi;
};
__device__ __forceinline__ char* WS(const Params& p) { int z = 0; asm volatile("" : "+s"(z)); return p.ws + z; }


__device__ __forceinline__ int TID() { int t = threadIdx.x; asm volatile("" : "+v"(t)); return t; }
__device__ __forceinline__ int BID() { int t = blockIdx.x; asm volatile("" : "+s"(t)); return t; }
__device__ __forceinline__ u16 f2bf(float f) {
  uint32_t u = __float_as_uint(f);
  u += 0x7fffu + ((u >> 16) & 1u);
  return (u16)(u >> 16);
}
__device__ __forceinline__ float bf2f(u16 h) { return __uint_as_float(((uint32_t)h) << 16); }
__device__ __forceinline__ float sigmoidf_(float x) { return __builtin_amdgcn_exp2f(-__builtin_amdgcn_logf(1.f + __expf(-x))); }
__device__ __forceinline__ f16 f2h(float v) { v = fminf(fmaxf(v, -60000.f), 60000.f); return (f16)v; }

template <int CTRL>
__device__ __forceinline__ float dpp_f(float x) {
  return __int_as_float(__builtin_amdgcn_update_dpp(0, __float_as_int(x), CTRL, 0xf, 0xf, true));
}
__device__ __forceinline__ float red8(float x) {
  x += dpp_f<0xB1>(x);
  x += dpp_f<0x4E>(x);
  x += dpp_f<0x141>(x);
  return x;
}
__device__ __forceinline__ float wave_sum(float v) {
#pragma unroll
  for (int o = 32; o > 0; o >>= 1) v += __shfl_xor(v, o, 64);
  return v;
}

__device__ __forceinline__ void gemm_loop(f32x4 (&acc)[4][4], const u16* __restrict__ A, int lda,
                                          const u16* __restrict__ Bt, int ldb, int K, char* lds) {
  const int tid = TID();
  const int lane = tid & 63, wave = tid >> 6;
  const int wm = wave >> 1, wn = wave & 1;
  u16* s0 = (u16*)lds;
  const int lr = tid >> 3, lc = (tid & 7) * 8;
  const u16* ap0 = A + (size_t)lr * lda + lc;
  const u16* ap1 = ap0 + (size_t)64 * lda;
  const u16* ap2 = ap0 + (size_t)128 * lda;
  const u16* ap3 = ap0 + (size_t)192 * lda;
  const u16* bp0 = Bt + (size_t)lr * ldb + lc;
  const u16* bp1 = bp0 + (size_t)64 * ldb;
  const int KT = K >> 6;
  const int wofa = lr * LDT + lc;
  const int wofb = 256 * LDT + wofa;
  const int arow = (wm * 64 + (lane & 15)) * LDT + (lane >> 4) * 8;
  const int brow = (wn * 64 + (lane & 15)) * LDT + (lane >> 4) * 8;
#define G_LOAD(S, kt_) do { const int ko_ = (kt_) * 64; \
    S##a0 = *(const uint4*)(ap0 + ko_); S##a1 = *(const uint4*)(ap1 + ko_); S##a2 = *(const uint4*)(ap2 + ko_); S##a3 = *(const uint4*)(ap3 + ko_); \
    S##b0 = *(const uint4*)(bp0 + ko_); S##b1 = *(const uint4*)(bp1 + ko_); } while (0)
#define G_WRITE(S, st_) do { u16* w_ = s0 + (st_) * STAGE_ELEMS; \
    *(uint4*)(w_ + wofa) = S##a0; *(uint4*)(w_ + wofa + 64 * LDT) = S##a1; *(uint4*)(w_ + wofa + 128 * LDT) = S##a2; *(uint4*)(w_ + wofa + 192 * LDT) = S##a3; \
    *(uint4*)(w_ + wofb) = S##b0; *(uint4*)(w_ + wofb + 64 * LDT) = S##b1; } while (0)
#define MF(i, j, av, bv) acc[i][j] = __builtin_amdgcn_mfma_f32_16x16x32_bf16(av, bv, acc[i][j], 0, 0, 0)
#define G_COMPUTE(st_) do { const u16* sa = s0 + (st_) * STAGE_ELEMS; const u16* sb = sa + 256 * LDT; \
    _Pragma("unroll") for (int ks = 0; ks < 2; ++ks) { \
      const bf16x8 a0 = *(const bf16x8*)(sa + arow + ks * 32); \
      const bf16x8 a1 = *(const bf16x8*)(sa + arow + 16 * LDT + ks * 32); \
      const bf16x8 a2 = *(const bf16x8*)(sa + arow + 32 * LDT + ks * 32); \
      const bf16x8 a3 = *(const bf16x8*)(sa + arow + 48 * LDT + ks * 32); \
      const bf16x8 b0 = *(const bf16x8*)(sb + brow + ks * 32); \
      const bf16x8 b1 = *(const bf16x8*)(sb + brow + 16 * LDT + ks * 32); \
      const bf16x8 b2 = *(const bf16x8*)(sb + brow + 32 * LDT + ks * 32); \
      const bf16x8 b3 = *(const bf16x8*)(sb + brow + 48 * LDT + ks * 32); \
      MF(0, 0, a0, b0); MF(0, 1, a0, b1); MF(0, 2, a0, b2); MF(0, 3, a0, b3); \
      MF(1, 0, a1, b0); MF(1, 1, a1, b1); MF(1, 2, a1, b2); MF(1, 3, a1, b3); \
      MF(2, 0, a2, b0); MF(2, 1, a2, b1); MF(2, 2, a2, b2); MF(2, 3, a2, b3); \
      MF(3, 0, a3, b0); MF(3, 1, a3, b1); MF(3, 2, a3, b2); MF(3, 3, a3, b3); } } while (0)
  uint4 Pa0, Pa1, Pa2, Pa3, Pb0, Pb1, Qa0, Qa1, Qa2, Qa3, Qb0, Qb1;
  __syncthreads();
  G_LOAD(P, 0);
  G_WRITE(P, 0);
  if (KT == 1) {
    __syncthreads();
    G_COMPUTE(0);
    __syncthreads();
  } else if (KT == 2) {
    G_LOAD(P, 1);
    __syncthreads();
    G_COMPUTE(0);
    G_WRITE(P, 1);
    __syncthreads();
    G_COMPUTE(1);
    __syncthreads();
  } else {
    G_LOAD(P, 1);
    G_LOAD(Q, 2);
    __syncthreads();
    int kt = 0;
    for (; kt + 4 < KT; kt += 2) {
      G_COMPUTE(0);
      G_WRITE(P, 1);
      G_LOAD(P, kt + 3);
      __syncthreads();
      G_COMPUTE(1);
      G_WRITE(Q, 0);
      G_LOAD(Q, kt + 4);
      __syncthreads();
    }
    G_COMPUTE(0);
    G_WRITE(P, 1);
    G_LOAD(P, kt + 3);
    __syncthreads();
    G_COMPUTE(1);
    G_WRITE(Q, 0);
    __syncthreads();
    G_COMPUTE(0);
    G_WRITE(P, 1);
    __syncthreads();
    G_COMPUTE(1);
    __syncthreads();
  }
#undef G_LOAD
#undef G_WRITE
#undef G_COMPUTE
#undef MF
}

__device__ __forceinline__ void acc_zero(f32x4 (&acc)[4][4]) {
#pragma unroll
  for (int i = 0; i < 4; ++i)
#pragma unroll
    for (int j = 0; j < 4; ++j) acc[i][j] = f32x4{0.f, 0.f, 0.f, 0.f};
}

template <class F>
__device__ __forceinline__ void epi_apply(f32x4 (&acc)[4][4], char* lds, F f) {
  const int lane = TID() & 63, wave = TID() >> 6;
  const int wm = wave >> 1, wn = wave & 1;
  float* sw = (float*)lds + wave * (32 * 68);
#pragma unroll
  for (int hp = 0; hp < 2; ++hp) {
#pragma unroll
    for (int m2 = 0; m2 < 2; ++m2)
#pragma unroll
      for (int nf = 0; nf < 4; ++nf)
#pragma unroll
        for (int r = 0; r < 4; ++r)
          sw[(m2 * 16 + (lane >> 4) * 4 + r) * 68 + nf * 16 + (lane & 15)] = acc[hp * 2 + m2][nf][r];
    __builtin_amdgcn_wave_barrier();
#pragma unroll
    for (int i = 0; i < 4; ++i) {
      const int rr = i * 8 + (lane >> 3), cc = (lane & 7) * 8;
      const float4 a = *(const float4*)(sw + rr * 68 + cc), b = *(const float4*)(sw + rr * 68 + cc + 4);
      float v[8] = {a.x, a.y, a.z, a.w, b.x, b.y, b.z, b.w};
      f(wm * 64 + hp * 32 + rr, wn * 64 + cc, v);
    }
    __builtin_amdgcn_wave_barrier();
  }
}

__device__ __forceinline__ u16x8 pack_bf8(const float (&v)[8]) {
  u16x8 o;
#pragma unroll
  for (int j = 0; j < 8; ++j) o[j] = f2bf(v[j]);
  return o;
}
__device__ __forceinline__ f16x8 pack_h8(const float (&v)[8]) {
  f16x8 o;
#pragma unroll
  for (int j = 0; j < 8; ++j) o[j] = f2h(v[j]);
  return o;
}

__device__ void copy_f4(const float* __restrict__ src, float* __restrict__ dst, size_t n4) {
  const float4* s = (const float4*)src; float4* d = (float4*)dst;
  for (size_t i = (size_t)BID() * NTHREADS + TID(); i < n4; i += (size_t)gridDim.x * NTHREADS) d[i] = s[i];
}

__device__ void mod_phase(const Params& p, char* lds) {
  float* sl = (float*)lds;
  float* red = sl + 9 * 1024;
  float* MOD = (float*)(WS(p) + OFF_MOD);
  const int tid = TID(), lane = tid & 63, wave = tid >> 6;
  __syncthreads();
  for (int i = tid; i < 9 * 1024; i += NTHREADS) {
    float v = (i < 8 * 1024) ? p.c[i] : p.c_ctx[i - 8 * 1024];
    sl[i] = v * sigmoidf_(v);
  }
  __syncthreads();
  for (int item = BID(); item < 192; item += gridDim.x) {
    const int l = item / 96, n0 = (item % 96) * 64;
    const float* w = p.w_mod + (size_t)l * 1024 * 6144 + n0 + lane;
    float acc[9];
#pragma unroll
    for (int r = 0; r < 9; ++r) acc[r] = 0.f;
    const int kbeg = wave * 128;
#pragma unroll 1
    for (int kb = kbeg; kb < kbeg + 128; kb += 32) {
      float wv[32];
#pragma unroll
      for (int i = 0; i < 32; ++i) wv[i] = w[(size_t)(kb + i) * 6144];
#pragma unroll
      for (int i4 = 0; i4 < 8; ++i4) {
#pragma unroll
        for (int r = 0; r < 9; ++r) {
          const float4 s4 = *(const float4*)(sl + r * 1024 + kb + i4 * 4);
          acc[r] += s4.x * wv[i4 * 4] + s4.y * wv[i4 * 4 + 1] + s4.z * wv[i4 * 4 + 2] + s4.w * wv[i4 * 4 + 3];
        }
      }
    }
#pragma unroll
    for (int r = 0; r < 9; ++r) red[(wave * 9 + r) * 64 + lane] = acc[r];
    __syncthreads();
    for (int i = tid; i < 9 * 64; i += NTHREADS) {
      int r = i >> 6, ln = i & 63;
      float s = 0.f;
#pragma unroll
      for (int w8 = 0; w8 < 8; ++w8) s += red[(w8 * 9 + r) * 64 + ln];
      MOD[((size_t)l * 9 + r) * 6144 + n0 + ln] = s + p.b_mod[(size_t)l * 6144 + n0 + ln];
    }
    __syncthreads();
  }
}

struct ConvTile { const float* src; u16* dst; int K, N, k0, n0; };

__device__ __forceinline__ ConvTile conv_tile_params(const Params& p, int l, int set, int t) {
  char* wta = WS(p) + OFF_WTA;
  int tt = t;
  const float* src; int K, N; u16* dst;
  if (set == 0) {
    if (tt < 1120) { src = p.w_in + (size_t)l * 1024 * 4480; K = 1024; N = 4480; dst = (u16*)(wta + WO_IN); }
    else if ((tt -= 1120) < 128) { src = p.w_fourier_up + (size_t)l * 512 * 1024; K = 512; N = 1024; dst = (u16*)(wta + WO_FU); }
    else if ((tt -= 128) < 128) { src = p.w_rwkv_up + (size_t)l * 512 * 1024; K = 512; N = 1024; dst = (u16*)(wta + WO_RU); }
    else if ((tt -= 128) < 256) { src = p.w_out + (size_t)l * 1024 * 1024; K = 1024; N = 1024; dst = (u16*)(wta + WO_OUT); }
    else if ((tt -= 256) < 16) { const int d = tt >> 3; tt &= 7; src = p.w_up + (size_t)(l * 2 + d) * 64 * 512; K = 64; N = 512; dst = (u16*)(wta + WO_WUP) + d * 512 * 64; }
    else if ((tt -= 16) < 16) { const int d = tt >> 3; tt &= 7; src = p.a_up + (size_t)(l * 2 + d) * 64 * 512; K = 64; N = 512; dst = (u16*)(wta + WO_AUP) + d * 512 * 64; }
    else { tt -= 16; src = p.g_up + (size_t)l * 128 * 512; K = 128; N = 512; dst = (u16*)(wta + WO_GUP); }
  } else {
    if (tt < 1024) { src = p.mlp_w1 + (size_t)l * 1024 * 4096; K = 1024; N = 4096; dst = (u16*)(WS(p) + OFF_W1T); }
    else { tt -= 1024; src = p.mlp_w2 + (size_t)l * 4096 * 1024; K = 4096; N = 1024; dst = (u16*)(WS(p) + OFF_W2T); }
  }
  const int nT = N >> 6;
  ConvTile c; c.src = src; c.dst = dst; c.K = K; c.N = N; c.k0 = (tt / nT) * 64; c.n0 = (tt % nT) * 64;
  return c;
}

__device__ void conv_phase(const Params& p, int l, int set, char* lds, int first = -1, int stride = 0) {
  float* tileA = (float*)lds;
  float* tileB = tileA + 64 * 65;
  const int tid = TID();
  const int total = (set == 0) ? 1680 : 2048;
  const int t0 = (first < 0) ? BID() : first, tstep = (first < 0) ? (int)gridDim.x : stride;
  if (t0 >= total) return;
  const int lk = tid >> 6, ln = tid & 63;
  const int sn = tid >> 3, skc = (tid & 7) * 8;
  float a0, a1, a2, a3, a4, a5, a6, a7, b0, b1, b2, b3, b4, b5, b6, b7;
#define CONV_LOAD(c, R) do { const float* q_ = (c).src + (size_t)((c).k0 + lk) * (c).N + (c).n0 + ln; const size_t st_ = (size_t)8 * (c).N; \
    R##0 = q_[0]; R##1 = q_[st_]; R##2 = q_[2 * st_]; R##3 = q_[3 * st_]; R##4 = q_[4 * st_]; R##5 = q_[5 * st_]; R##6 = q_[6 * st_]; R##7 = q_[7 * st_]; } while (0)
#define CONV_PUT(T, R) do { T[(lk + 0) * 65 + ln] = R##0; T[(lk + 8) * 65 + ln] = R##1; T[(lk + 16) * 65 + ln] = R##2; T[(lk + 24) * 65 + ln] = R##3; \
    T[(lk + 32) * 65 + ln] = R##4; T[(lk + 40) * 65 + ln] = R##5; T[(lk + 48) * 65 + ln] = R##6; T[(lk + 56) * 65 + ln] = R##7; } while (0)
#define CONV_OUT(T, c) do { u16x8 o_; _Pragma("unroll") for (int j = 0; j < 8; ++j) o_[j] = f2bf(T[(skc + j) * 65 + sn]); \
    *(u16x8*)((c).dst + (size_t)((c).n0 + sn) * (c).K + (c).k0 + skc) = o_; } while (0)
  ConvTile ca = conv_tile_params(p, l, set, t0), cb = ca;
  bool hasb = (t0 + tstep) < total;
  CONV_LOAD(ca, a);
  if (hasb) { cb = conv_tile_params(p, l, set, t0 + tstep); CONV_LOAD(cb, b); }
  for (int t = t0; t < total; t += 2 * tstep) {
    __syncthreads();
    CONV_PUT(tileA, a);
    if (hasb) CONV_PUT(tileB, b);
    __syncthreads();
    const ConvTile da = ca, db = cb;
    const bool hadb = hasb;
    if (t + 2 * tstep < total) { ca = conv_tile_params(p, l, set, t + 2 * tstep); CONV_LOAD(ca, a); }
    hasb = (t + 3 * tstep) < total;
    if (hasb) { cb = conv_tile_params(p, l, set, t + 3 * tstep); CONV_LOAD(cb, b); }
    CONV_OUT(tileA, da);
    if (hadb) CONV_OUT(tileB, db);
  }
#undef CONV_LOAD
#undef CONV_PUT
#undef CONV_OUT
  __syncthreads();
}

__device__ void dftm_gen(const Params& p, char* lds) {
  u16* DM = (u16*)(WS(p) + OFF_AR);
  u16* tc = (u16*)lds;
  u16* ts = tc + 2048;
  const int tid = TID();
  const float TWO_PI = 6.283185307179586f;
  __syncthreads();
  for (int m = tid; m < 2048; m += NTHREADS) {
    float sn, cs;
    sincosf(TWO_PI * (float)m * (1.f / 2048.f), &sn, &cs);
    tc[m] = f2bf(cs);
    ts[m] = f2bf(-sn);
  }
  __syncthreads();
  const int gt = BID() * NTHREADS + tid, gs = gridDim.x * NTHREADS;
  for (int i = gt; i < 2048 * 256; i += gs) {
    const int k = i >> 8, c0 = (i & 255) * 8;
    const u16* tab = (c0 < 1024) ? tc : ts;
    const int l0 = c0 & 1023;
    u16x8 o;
#pragma unroll
    for (int j = 0; j < 8; ++j) o[j] = tab[(k * (l0 + j)) & 2047];
    *(u16x8*)(DM + (size_t)k * 2048 + c0) = o;
  }
  for (int i = gt; i < 256 * 32; i += gs) {
    const int k = i >> 5, l0 = (i & 31) * 8;
    u16x8 oc, os;
#pragma unroll
    for (int j = 0; j < 8; ++j) { const int m = ((k * (l0 + j)) & 255) * 8; oc[j] = tc[m]; os[j] = ts[m]; }
    *(u16x8*)(DM + DM_CC + (size_t)k * 256 + l0) = oc;
    *(u16x8*)(DM + DM_NSC + (size_t)k * 256 + l0) = os;
  }
  for (int i = gt; i < 256 * 16; i += gs) {
    const int row = i >> 4, c0 = (i & 15) * 8, jj = row & 127;
    u16x8 o;
#pragma unroll
    for (int j = 0; j < 8; ++j) { const int m = ((jj * (c0 + j)) & 127) * 16; o[j] = (row < 128) ? tc[m] : (u16)(ts[m] ^ 0x8000u); }
    *(u16x8*)(DM + DM_TW + (size_t)row * 128 + c0) = o;
  }
}

__device__ void normmod_phase(const Params& p, int l, int which, int ntok, u16* __restrict__ H, bool from_inputs, const u16* D = nullptr, const u16* PARTp = nullptr, const float* pgate = nullptr) {
  const float* MOD = (const float*)(WS(p) + OFF_MOD);
  const float* XC = from_inputs ? p.ctx : (const float*)(WS(p) + OFF_XC);
  const float* XL = from_inputs ? p.x : p.out;
  float* WC = (float*)(WS(p) + OFF_XC);
  float* WL = p.out;
  const float* nw = (which == 0 ? p.norm1 : p.norm2) + l * 1024;
  const int lane = TID() & 63;
  const int gw = BID() * 8 + (TID() >> 6), nw_ = gridDim.x * 8;
  float4 vn[4];
  if (gw < ntok) {
    const float* x0 = (gw < TL) ? (XL + (size_t)gw * 1024) : (XC + (size_t)(gw - TL) * 1024);
#pragma unroll
    for (int j = 0; j < 4; ++j) vn[j] = *(const float4*)(x0 + j * 256 + lane * 4);
  }
  for (int t = gw; t < ntok; t += nw_) {
    const size_t roff = (t < TL) ? ((size_t)t * 1024) : ((size_t)(t - TL) * 1024);
    const int mrow = (t < TL) ? (t >> 11) : 8;
    const float* mo = MOD + ((size_t)l * 9 + mrow) * 6144 + which * 3072;
    float4 v[4];
    ushort4 dq[4];
#pragma unroll
    for (int j = 0; j < 4; ++j) v[j] = vn[j];
    {
      const int t2 = t + nw_;
      if (t2 < ntok) {
        const float* x2 = (t2 < TL) ? (XL + (size_t)t2 * 1024) : (XC + (size_t)(t2 - TL) * 1024);
#pragma unroll
        for (int j = 0; j < 4; ++j) vn[j] = *(const float4*)(x2 + j * 256 + lane * 4);
      }
    }
    const bool ctxpart = PARTp && t >= TL;
    if (ctxpart) {
#pragma unroll
      for (int j = 0; j < 4; ++j) {
        const int c0 = j * 256 + lane * 4;
        float sx = 0.f, sy = 0.f, sz = 0.f, sw = 0.f;
#pragma unroll
        for (int ks = 0; ks < 4; ++ks) {
          const ushort4 q = *(const ushort4*)(PARTp + ((size_t)ks * 2048 + (t - TL)) * 1024 + c0);
          sx += bf2f(q.x); sy += bf2f(q.y); sz += bf2f(q.z); sw += bf2f(q.w);
        }
        float4 gg = float4{1.f, 1.f, 1.f, 1.f};
        if (pgate) gg = *(const float4*)(pgate + c0);
        v[j].x += gg.x * sx; v[j].y += gg.y * sy; v[j].z += gg.z * sz; v[j].w += gg.w * sw;
      }
      if (D) {
        float* xw = WC + roff;
#pragma unroll
        for (int j = 0; j < 4; ++j) *(float4*)(xw + j * 256 + lane * 4) = v[j];
      }
    }
    if (D && !ctxpart) {
#pragma unroll
      for (int j = 0; j < 4; ++j) dq[j] = *(const ushort4*)(D + (size_t)t * 1024 + j * 256 + lane * 4);
      float* xw = ((t < TL) ? WL : WC) + roff;
#pragma unroll
      for (int j = 0; j < 4; ++j) {
        v[j].x += bf2f(dq[j].x); v[j].y += bf2f(dq[j].y); v[j].z += bf2f(dq[j].z); v[j].w += bf2f(dq[j].w);
        *(float4*)(xw + j * 256 + lane * 4) = v[j];
      }
    }
    float ss = 0.f;
#pragma unroll
    for (int j = 0; j < 4; ++j) ss += v[j].x * v[j].x + v[j].y * v[j].y + v[j].z * v[j].z + v[j].w * v[j].w;
    ss = wave_sum(ss);
    const float inv = rsqrtf(ss * (1.f / 1024.f) + 1e-6f);
#pragma unroll
    for (int j = 0; j < 4; ++j) {
      const int c0 = j * 256 + lane * 4;
      float4 g = *(const float4*)(nw + c0);
      float4 sh = *(const float4*)(mo + c0);
      float4 sc = *(const float4*)(mo + 1024 + c0);
      ushort4 o;
      o.x = f2bf(v[j].x * inv * g.x * (1.f + sc.x) + sh.x);
      o.y = f2bf(v[j].y * inv * g.y * (1.f + sc.y) + sh.y);
      o.z = f2bf(v[j].z * inv * g.z * (1.f + sc.z) + sh.z);
      o.w = f2bf(v[j].w * inv * g.w * (1.f + sc.w) + sh.w);
      *(ushort4*)(H + (size_t)t * 1024 + c0) = o;
    }
  }
}

__device__ void final_norm(const Params& p) {
  const u16* D2 = (const u16*)(WS(p) + OFF_EH);
  const int lane = TID() & 63;
  const int gw = BID() * 8 + (TID() >> 6), nw_ = gridDim.x * 8;
  for (int t = gw; t < TL; t += nw_) {
    float* xr = p.out + (size_t)t * 1024;
    float4 v[4];
    float ss = 0.f;
#pragma unroll
    for (int j = 0; j < 4; ++j) {
      v[j] = *(const float4*)(xr + j * 256 + lane * 4);
      const ushort4 dq = *(const ushort4*)(D2 + (size_t)t * 1024 + j * 256 + lane * 4);
      v[j].x += bf2f(dq.x); v[j].y += bf2f(dq.y); v[j].z += bf2f(dq.z); v[j].w += bf2f(dq.w);
      ss += v[j].x * v[j].x + v[j].y * v[j].y + v[j].z * v[j].z + v[j].w * v[j].w;
    }
    ss = wave_sum(ss);
    const float inv = rsqrtf(ss * (1.f / 1024.f) + 1e-6f);
#pragma unroll
    for (int j = 0; j < 4; ++j) {
      const int c0 = j * 256 + lane * 4;
      float4 g = *(const float4*)(p.norm_f + c0);
      float4 o;
      o.x = v[j].x * inv * g.x; o.y = v[j].y * inv * g.y; o.z = v[j].z * inv * g.z; o.w = v[j].w * inv * g.w;
      *(float4*)(xr + c0) = o;
    }
  }
}

__device__ void prep3a_phase(const Params& p, int l) {
  const f16* RW = (const f16*)(WS(p) + OFF_RW);
  f16* Rb = (f16*)(WS(p) + OFF_R);
  f16* Kb = (f16*)(WS(p) + OFF_K);
  f16* Vb = (f16*)(WS(p) + OFF_V);
  u16* LORA = (u16*)(WS(p) + OFF_LORA);
  u16* GDS = (u16*)(WS(p) + OFF_GDS);
  float* INVN = (float*)(WS(p) + OFF_INVN);
  const float* mu = p.mu_shift + (size_t)l * 1920;
  const float* kk_w = p.k_k + (size_t)l * 512;
  const int lane = TID() & 63;
  const int gw = BID() * 8 + (TID() >> 6), nw_ = gridDim.x * 8;
  float mm[4][8], kw[8];
  bool valid[4];
#pragma unroll
  for (int it = 0; it < 4; ++it) {
    const int chunk = it * 64 + lane;
    valid[it] = chunk < 240;
    const int c0 = valid[it] ? chunk * 8 : 0;
    const float4 m0 = *(const float4*)(mu + c0), m1 = *(const float4*)(mu + c0 + 4);
    mm[it][0] = m0.x; mm[it][1] = m0.y; mm[it][2] = m0.z; mm[it][3] = m0.w;
    mm[it][4] = m1.x; mm[it][5] = m1.y; mm[it][6] = m1.z; mm[it][7] = m1.w;
  }
  {
    const float4 k0 = *(const float4*)(kk_w + lane * 8), k1 = *(const float4*)(kk_w + lane * 8 + 4);
    kw[0] = k0.x; kw[1] = k0.y; kw[2] = k0.z; kw[3] = k0.w; kw[4] = k1.x; kw[5] = k1.y; kw[6] = k1.z; kw[7] = k1.w;
  }
  auto load_tok = [&](int t, f16x8 (&R)[4], f16x8 (&Nb)[4]) {
    const bool lat = t < TL;
    int pos, row = 0, colg = 0;
    if (lat) { pos = t & 2047; row = pos >> 6; colg = pos & 63; } else { pos = (t - TL) & 255; }
#pragma unroll
    for (int it = 0; it < 4; ++it) {
      const int chunk = it * 64 + lane;
      const int c0 = chunk * 8;
      int nb = -1;
      if (lat) {
        const int q = c0 / 480;
        if (q == 0) { if (colg > 0) nb = t - 1; }
        else if (q == 1) { if (colg < 63) nb = t + 1; }
        else if (q == 2) { if (row > 0) nb = t - 64; }
        else { if (row < 31) nb = t + 64; }
      } else {
        if (c0 < 960) { if (pos > 0) nb = t - 1; }
        else { if (pos < 255) nb = t + 1; }
      }
#pragma unroll
      for (int j = 0; j < 8; ++j) { R[it][j] = (f16)0.f; Nb[it][j] = (f16)0.f; }
      if (valid[it]) {
        R[it] = *(const f16x8*)(RW + (size_t)t * 1920 + c0);
        if (nb >= 0) Nb[it] = *(const f16x8*)(RW + (size_t)nb * 1920 + c0);
      }
    }
  };
  f16x8 nraw[4], nnbv[4];
  if (gw < TA) load_tok(gw, nraw, nnbv);
  for (int t = gw; t < TA; t += nw_) {
    f16x8 raw[4], nbv[4];
#pragma unroll
    for (int it = 0; it < 4; ++it) { raw[it] = nraw[it]; nbv[it] = nnbv[it]; }
    if (t + nw_ < TA) load_tok(t + nw_, nraw, nnbv);
#pragma unroll
    for (int it = 0; it < 4; ++it) {
      const int chunk = it * 64 + lane;
      if (valid[it]) {
        const int c0 = chunk * 8;
        float s[8];
#pragma unroll
        for (int j = 0; j < 8; ++j) {
          float a = (float)raw[it][j], b = (float)nbv[it][j];
          s[j] = a + mm[it][j] * (b - a);
        }
        if (it < 3) {
          f16x8 o;
#pragma unroll
          for (int j = 0; j < 8; ++j) o[j] = f2h(s[j]);
          f16* dst = (it == 0) ? Rb : ((it == 1) ? Kb : Vb);
          *(f16x8*)(dst + (size_t)t * 512 + (c0 - it * 512)) = o;
          if (it == 1) {
            float ss = 0.f;
#pragma unroll
            for (int j = 0; j < 8; ++j) { float q = (float)o[j] * kw[j]; ss += q * q; }
            ss = red8(ss);
            if ((lane & 7) == 0) INVN[(size_t)t * 8 + (lane >> 3)] = 1.f / fmaxf(sqrtf(ss), 1e-12f);
          }
        } else if (c0 < 1792) {
          u16x8 o;
          const bool th = c0 < 1664;
#pragma unroll
          for (int j = 0; j < 8; ++j) o[j] = f2bf(th ? tanhf(s[j]) : s[j]);
          *(u16x8*)(LORA + (size_t)t * 256 + (c0 - 1536)) = o;
        } else {
          u16x8 o;
#pragma unroll
          for (int j = 0; j < 8; ++j) o[j] = f2bf(sigmoidf_(s[j]));
          *(u16x8*)(GDS + (size_t)t * 128 + (c0 - 1792)) = o;
        }
      }
    }
  }
}

__device__ void post5a_phase(const Params& p, int l, int ntok) {
  const f16* Rb = (const f16*)(WS(p) + OFF_R);
  const f16* Kb = (const f16*)(WS(p) + OFF_K);
  const f16* Vb = (const f16*)(WS(p) + OFF_V);
  const f16* A0 = (const f16*)(WS(p) + OFF_AR);
  const f16* A1 = A0 + (size_t)TA * 512;
  f16* Y0 = (f16*)(WS(p) + OFF_YS0);
  const f16* Y1 = (const f16*)(WS(p) + OFF_YS1);
  const int lane = TID() & 63;
  const int c0 = lane * 8;
  float ka[8], rk[8], lw[8], lb[8];
#pragma unroll
  for (int j = 0; j < 8; ++j) {
    ka[j] = p.k_a[l * 512 + c0 + j];
    rk[j] = p.r_k[l * 512 + c0 + j];
    lw[j] = p.ln_x_w[l * 512 + c0 + j];
    lb[j] = p.ln_x_b[l * 512 + c0 + j];
  }
  const int gw = BID() * 8 + (TID() >> 6), nw_ = gridDim.x * 8;
  for (int t = gw; t < ntok; t += nw_) {
    const size_t o = (size_t)t * 512 + c0;
    f16x8 r = *(const f16x8*)(Rb + o), k = *(const f16x8*)(Kb + o), v = *(const f16x8*)(Vb + o);
    f16x8 a0 = *(const f16x8*)(A0 + o), a1 = *(const f16x8*)(A1 + o);
    f16x8 y0 = *(const f16x8*)(Y0 + o), y1 = *(const f16x8*)(Y1 + o);
    float y[8], bs = 0.f, sum = 0.f;
#pragma unroll
    for (int j = 0; j < 8; ++j) {
      float kf = (float)k[j];
      float kd0 = kf * (1.f + ((float)a0[j] - 1.f) * ka[j]);
      float kd1 = kf * (1.f + ((float)a1[j] - 1.f) * ka[j]);
      bs += (float)r[j] * (kd0 + kd1) * rk[j];
      y[j] = (float)y0[j] + (float)y1[j];
      sum += y[j];
    }
    bs = red8(bs);
    sum = red8(sum);
    const float mean = sum * (1.f / 64.f);
    float vs = 0.f;
#pragma unroll
    for (int j = 0; j < 8; ++j) { float d = y[j] - mean; vs += d * d; }
    vs = red8(vs);
    const float rstd = rsqrtf(vs * (1.f / 64.f) + 64e-5f);
    u16x8 z;
#pragma unroll
    for (int j = 0; j < 8; ++j) {
      float yn = (y[j] - mean) * rstd * lw[j] + lb[j];
      z[j] = f2bf(yn + bs * (float)v[j]);
    }
    *(u16x8*)((u16*)Y0 + o) = z;
  }
}

constexpr int TB = 32;
constexpr int NBLK = 2304 / TB;
constexpr int ST_VEC = TB * 320;
constexpr int ST_FLOATS = ST_VEC + TB * 32 * 2;

__device__ __forceinline__ int scan_token(int d, int b, int s) {
  if (s < 256) return TL + b * 256 + (d == 0 ? s : 255 - s);
  const int s2 = s - 256;
  return b * 2048 + (d == 0 ? s2 : 2047 - s2);
}

__device__ __forceinline__ float red16(float x) {
  x += dpp_f<0xB1>(x);
  x += dpp_f<0x4E>(x);
  x += dpp_f<0x141>(x);
  x += dpp_f<0x140>(x);
  return x;
}

constexpr int SC_VEC = TB * 256;
constexpr int SC_P = SC_VEC;
constexpr int SC_V = SC_VEC + 64;
constexpr int SC_Y = SC_V + TB * 32;
constexpr int SC_FLOATS = SC_Y + TB * 32;

#define SCAN_BAR() do { asm volatile("s_waitcnt lgkmcnt(0)" ::: "memory"); __builtin_amdgcn_s_barrier(); asm volatile("" ::: "memory"); } while (0)
__device__ void scan_phase(const Params& p, int l, char* lds) {
  float* st = (float*)lds;
  const f16* Rb = (const f16*)(WS(p) + OFF_R);
  const f16* Kb = (const f16*)(WS(p) + OFF_K);
  const f16* Vb = (const f16*)(WS(p) + OFF_V);
  const float* INVN = (const float*)(WS(p) + OFF_INVN);
  const int tid = TID();
  for (int item = BID(); item < 256; item += gridDim.x) {
    const int chain = item >> 1, half = item & 1;
    const int d = chain >> 6, b = (chain >> 3) & 7, h = chain & 7;
    const f16* Eb = (const f16*)(WS(p) + OFF_EH) + (size_t)d * TA * 512;
    const f16* Ab = (const f16*)(WS(p) + OFF_AR) + (size_t)d * TA * 512;
    f16* Yb = (f16*)(WS(p) + (d == 0 ? OFF_YS0 : OFF_YS1));
    __syncthreads();
    if (__builtin_amdgcn_readfirstlane(tid >> 6) >= 4) {
      const int lt = tid - 256;
      const int k = lt & 63, sgp = __builtin_amdgcn_readfirstlane(lt >> 6);
      const int ch = h * 64 + k;
      const float kkw = p.k_k[l * 512 + ch], kaw = p.k_a[l * 512 + ch];
      const int vstep = lt >> 3, vcol = h * 64 + half * 32 + (lt & 7) * 4;
      f16 ev[TB], kv[8], rv[8], av[8];
      float invn[8];
      f16x4 vv;
      const int dir = d ? -1 : 1;
      auto issue = [&](int blk) {
        const int tok0 = __builtin_amdgcn_readfirstlane(scan_token(d, b, blk * TB));
        const f16* pe = Eb + (size_t)tok0 * 512;
#pragma unroll
        for (int t = 0; t < TB; ++t) ev[t] = pe[(ptrdiff_t)(dir * t) * 512 + ch];
        const int tokg = __builtin_amdgcn_readfirstlane(tok0 + dir * sgp * 8);
#pragma unroll
        for (int j = 0; j < 8; ++j) {
          const ptrdiff_t o = (ptrdiff_t)(tokg + dir * j) * 512;
          kv[j] = (Kb + o)[ch]; rv[j] = (Rb + o)[ch]; av[j] = (Ab + o)[ch];
          invn[j] = INVN[(size_t)(tokg + dir * j) * 8 + h];
        }
        vv = *(const f16x4*)(Vb + (size_t)(tok0 + dir * vstep) * 512 + vcol);
      };
      auto commit = [&](int blk) {
        float* sg = st + (blk & 1) * SC_FLOATS;
        float cum = 0.f;
#pragma unroll
        for (int t = 0; t < TB; ++t) {
          cum += (t < sgp * 8) ? (float)ev[t] : 0.f;
        }
#pragma unroll
        for (int j = 0; j < 8; ++j) {
          float e = 0.f;
#pragma unroll
          for (int g = 0; g < 4; ++g) e = (sgp == g) ? (float)ev[g * 8 + j] : e;
          const float pprev = __expf(-cum);
          cum += e;
          const float pt = __expf(-cum), ipt = __expf(cum);
          const float kf = (float)kv[j], af = (float)av[j];
          const float q = kf * kkw * invn[j];
          float* base = sg + (sgp * 8 + j) * 256 + k;
          base[0] = q * pprev;
          base[64] = q * af * ipt;
          base[128] = kf * (1.f + (af - 1.f) * kaw) * ipt;
          base[192] = (float)rv[j] * pt;
        }
        if (sgp == 3) sg[SC_P + k] = __expf(-cum);
        *(float4*)(sg + SC_V + vstep * 32 + (lt & 7) * 4) = float4{(float)vv[0], (float)vv[1], (float)vv[2], (float)vv[3]};
      };
      auto store_y = [&](int blk) {
        const float* sg = st + (blk & 1) * SC_FLOATS;
        const int tok = __builtin_amdgcn_readfirstlane(scan_token(d, b, blk * TB)) + dir * vstep;
        const float4 yv = *(const float4*)(sg + SC_Y + vstep * 32 + (lt & 7) * 4);
        f16x4 o;
        o[0] = f2h(yv.x); o[1] = f2h(yv.y); o[2] = f2h(yv.z); o[3] = f2h(yv.w);
        *(f16x4*)(Yb + (size_t)tok * 512 + vcol) = o;
      };
      issue(0);
      commit(0);
      issue(1);
      __syncthreads();
      for (int blk = 0; blk < NBLK; ++blk) {
        if (blk + 1 < NBLK) commit(blk + 1);
        if (blk + 2 < NBLK) issue(blk + 2);
        if (blk > 0) store_y(blk - 1);
        SCAN_BAR();
      }
      store_y(NBLK - 1);
    } else {
      const int lane = tid & 63, wave = tid >> 6;
      const int rl = wave * 8 + (lane >> 3), kp = lane & 7;
      f32x2 SA = f32x2{0.f, 0.f}, SB = SA, SC = SA, SD = SA;
      __syncthreads();
      for (int blk = 0; blk < NBLK; ++blk) {
        float* sg = st + (blk & 1) * SC_FLOATS;
        const float* vb = sg + SC_V + rl;
        float* yb = sg + SC_Y + rl;
        float ys0 = 0.f, ys1 = 0.f, ys2 = 0.f, ys3 = 0.f;
        const float* base0 = sg + kp * 8;
        f32x4 q0 = *(const f32x4*)(base0 + 0), q1 = *(const f32x4*)(base0 + 4);
        f32x4 a0 = *(const f32x4*)(base0 + 64), a1 = *(const f32x4*)(base0 + 68);
        f32x4 d0 = *(const f32x4*)(base0 + 128), d1 = *(const f32x4*)(base0 + 132);
        f32x4 r0 = *(const f32x4*)(base0 + 192), r1 = *(const f32x4*)(base0 + 196);
        float vv = vb[0];
#pragma unroll
        for (int u = 0; u < TB; ++u) {
          f32x4 nq0, nq1, na0, na1, nd0, nd1, nr0, nr1;
          float nvv;
          if (u + 1 < TB) {
            const float* nb = base0 + (u + 1) * 256;
            nq0 = *(const f32x4*)(nb + 0); nq1 = *(const f32x4*)(nb + 4);
            na0 = *(const f32x4*)(nb + 64); na1 = *(const f32x4*)(nb + 68);
            nd0 = *(const f32x4*)(nb + 128); nd1 = *(const f32x4*)(nb + 132);
            nr0 = *(const f32x4*)(nb + 192); nr1 = *(const f32x4*)(nb + 196);
            nvv = vb[(u + 1) * 32];
          }
          __builtin_amdgcn_sched_barrier(0x7);
          f32x2 pp = SA * q0.xy;
          pp = __builtin_elementwise_fma(SB, q0.zw, pp);
          pp = __builtin_elementwise_fma(SC, q1.xy, pp);
          pp = __builtin_elementwise_fma(SD, q1.zw, pp);
          const float sa = red8(pp.x + pp.y);
          const f32x2 v2 = f32x2{vv, vv}, ns = f32x2{-sa, -sa};
          SA = __builtin_elementwise_fma(v2, d0.xy, SA);
          SB = __builtin_elementwise_fma(v2, d0.zw, SB);
          SC = __builtin_elementwise_fma(v2, d1.xy, SC);
          SD = __builtin_elementwise_fma(v2, d1.zw, SD);
          SA = __builtin_elementwise_fma(ns, a0.xy, SA);
          SB = __builtin_elementwise_fma(ns, a0.zw, SB);
          SC = __builtin_elementwise_fma(ns, a1.xy, SC);
          SD = __builtin_elementwise_fma(ns, a1.zw, SD);
          f32x2 yy = SA * r0.xy;
          yy = __builtin_elementwise_fma(SB, r0.zw, yy);
          yy = __builtin_elementwise_fma(SC, r1.xy, yy);
          yy = __builtin_elementwise_fma(SD, r1.zw, yy);
          const float y = red8(yy.x + yy.y);
          if (u < 8) ys0 = ((u & 7) == kp) ? y : ys0;
          else if (u < 16) ys1 = ((u & 7) == kp) ? y : ys1;
          else if (u < 24) ys2 = ((u & 7) == kp) ? y : ys2;
          else ys3 = ((u & 7) == kp) ? y : ys3;
          if (u + 1 < TB) { q0 = nq0; q1 = nq1; a0 = na0; a1 = na1; d0 = nd0; d1 = nd1; r0 = nr0; r1 = nr1; vv = nvv; }
        }
        {
          const f32x4 p0 = *(const f32x4*)(sg + SC_P + kp * 8), p1 = *(const f32x4*)(sg + SC_P + kp * 8 + 4);
          SA *= p0.xy; SB *= p0.zw; SC *= p1.xy; SD *= p1.zw;
        }
        yb[kp * 32] = ys0;
        yb[(8 + kp) * 32] = ys1;
        yb[(16 + kp) * 32] = ys2;
        yb[(24 + kp) * 32] = ys3;
        SCAN_BAR();
      }
    }
  }
}

namespace pg8 {
#define PG8_LAS __attribute__((address_space(3)))
typedef unsigned short bf16_t;
typedef short bf16x8 __attribute__((ext_vector_type(8)));
typedef float f32x4 __attribute__((ext_vector_type(4)));
typedef unsigned u32x4 __attribute__((ext_vector_type(4)));
constexpr int BM = 256, BK = 64, HALF = 128, HTB = HALF * BK * 2  , STAGE_BYTES = 8 * HTB, NXCD = 8, WGM = 8;

__host__ __device__ __forceinline__ int lds_byte(int r, int c) { const int st = (r >> 4) * 2 + (c >> 5), rr = r & 15, cc = c & 31, ob = rr * 64 + cc * 2; return st * 1024 + (ob ^ (((ob >> 9) & 1) << 5)); }
__host__ __device__ __forceinline__ void stage_rc(int b, int& R, int& C) { const int st = b / 1024, sb = b % 1024, swz = sb ^ (((sb >> 9) & 1) << 5); R = (st >> 1) * 16 + swz / 64; C = (st & 1) * 32 + (swz % 64) / 2; }
__host__ __device__ __forceinline__ int perm32(int rho) { const int n = rho >> 4, i = rho & 15; return 8 * (i >> 2) + 4 * n + (i & 3); }

struct Unit { int pm, pn; };
struct Gemm { const bf16_t* A; const bf16_t* Bt; int M, N, K; };

struct StaticOrder {
    int nM, nN, nwg, G, c;
    __host__ __device__ void init(int M, int N, int G_, int c_) { nM = M / BM; nN = N / BM; nwg = nM * nN; G = G_; c = c_; }
    __host__ __device__ bool next(int i, Unit& u) const {
        const long L = (long)i * G + c; if (L >= nwg) return false;
        int wgid = (int)L; { const int q = nwg / NXCD, r = nwg % NXCD, xcd = wgid % NXCD, off = wgid / NXCD; wgid = (xcd < r ? xcd * (q + 1) : r * (q + 1) + (xcd - r) * q) + off; }
        const int nig = WGM * nN, gid = wgid / nig, fm = gid * WGM, gsz = (nM - fm) < WGM ? (nM - fm) : WGM;
        u.pm = fm + ((wgid % nig) % gsz); u.pn = (wgid % nig) / gsz; return true;
    }
    __device__ __forceinline__ void a_ready(const Unit&) const {}
    __device__ __forceinline__ void done(const Unit&) const {}
};
__device__ __forceinline__ unsigned cvt_pk_bf16(float lo, float hi) { unsigned r; asm volatile("v_cvt_pk_bf16_f32 %0, %1, %2" : "=v"(r) : "v"(lo), "v"(hi)); return r; }
typedef float f32x2 __attribute__((ext_vector_type(2)));
template <class Epi, class Sched, bool STAMP = false>
__device__ __forceinline__ void gemm_phase(PG8_LAS unsigned char* lds, const Gemm g, const Sched& S, const Epi& E, unsigned long long* stamps) {
    const int tid = TID(), wid = __builtin_amdgcn_readfirstlane(tid >> 6), lane = tid & 63, wr = wid >> 2, wc = wid & 3, fr = lane & 15, fq = lane >> 4;
    const int K = g.K, nt = K / BK;
    int ts_lo = 0, ts_hi = 0, nts = 0; const unsigned long long rt_entry = STAMP ? (unsigned long long)wall_clock64() : 0ull;
#define PG8_STAMP() do { if (STAMP && wid == 0 && nts < 64) { const unsigned long long _c = (unsigned long long)clock64(); \
        ts_lo = (lane == nts) ? (int)(unsigned)_c : ts_lo; ts_hi = (lane == nts) ? (int)(unsigned)(_c >> 32) : ts_hi; ++nts; } } while (0)
    PG8_STAMP();
    unsigned voffA[2], voffB[2];
#pragma unroll
    for (int i = 0; i < 2; ++i) { int R, C; stage_rc(tid * 16 + i * 8192, R, C); const int Rb = Epi::PERM ? ((R & ~31) + perm32(R & 31)) : R;
        voffA[i] = (unsigned)(R * K + C) * 2u; voffB[i] = (unsigned)(Rb * K + C) * 2u; }
    const size_t kstep = (size_t)(BK * 2);
    const size_t hstep = (size_t)HALF * K * 2;
    const size_t tstep = 2 * hstep;
    const unsigned ldsw = (unsigned)wid * 1024u;
    const int aoff = lds_byte(wr * 64 + fr, fq * 8), boff = lds_byte(wc * 32 + fr, fq * 8);
#define PG8_SA(b, h) (((b) * 2 + (h)) * HTB)
#define PG8_SB(b, h) ((4 + (b) * 2 + (h)) * HTB)
#define PG8_STAGE(bufoff, gbase, voff) do { _Pragma("unroll") for (int _i = 0; _i < 2; ++_i) \
        __builtin_amdgcn_global_load_lds((const unsigned*)((const char*)(gbase) + (voff)[_i]), (PG8_LAS unsigned*)(lds + (bufoff) + ldsw + _i * 8192), 16, 0, 0); } while (0)
#define PG8_LDA(dst, b, h) do { _Pragma("unroll") for (int m = 0; m < 4; ++m) _Pragma("unroll") for (int k = 0; k < 2; ++k) dst[m][k] = *(const PG8_LAS bf16x8*)(lds + PG8_SA(b, h) + aoff + m * 2048 + k * 1024); } while (0)
#define PG8_LDB(dst, b, h) do { _Pragma("unroll") for (int n = 0; n < 2; ++n) _Pragma("unroll") for (int k = 0; k < 2; ++k) dst[n][k] = *(const PG8_LAS bf16x8*)(lds + PG8_SB(b, h) + boff + n * 2048 + k * 1024); } while (0)
#define PG8_MMA(ai, bj, At, Bt) do { __builtin_amdgcn_s_setprio(1); _Pragma("unroll") for (int m = 0; m < 4; ++m) _Pragma("unroll") for (int n = 0; n < 2; ++n) _Pragma("unroll") for (int k = 0; k < 2; ++k) \
        acc[ai][bj][m][n] = __builtin_amdgcn_mfma_f32_16x16x32_bf16(Bt[n][k], At[m][k], acc[ai][bj][m][n], 0, 0, 0); __builtin_amdgcn_s_setprio(0); } while (0)
#define PG8_WAIT_V(n) asm volatile("s_waitcnt vmcnt(" #n ")" ::: "memory")
#define PG8_WAIT_L(n) asm volatile("s_waitcnt lgkmcnt(" #n ")" ::: "memory")
#define PG8_BAR __builtin_amdgcn_s_barrier()
#define PG8_SCHED __builtin_amdgcn_sched_barrier(0)
    Unit cur, nxt; int ui = 0;
    if (!S.next(0, cur)) return;
    f32x4 acc[2][2][4][2];
#pragma unroll
    for (int a = 0; a < 2; ++a)
#pragma unroll
        for (int b = 0; b < 2; ++b)
#pragma unroll
            for (int m = 0; m < 4; ++m)
#pragma unroll
                for (int n = 0; n < 2; ++n) acc[a][b][m][n] = (f32x4){0.f, 0.f, 0.f, 0.f};
    bf16x8 At[4][2], B0[2][2], B1[2][2];
    const char* cA = (const char*)g.A + (size_t)cur.pm * tstep; const char* cB = (const char*)g.Bt + (size_t)cur.pn * tstep;
    S.a_ready(cur);
    PG8_STAGE(PG8_SB(0, 0), cB, voffB); PG8_STAGE(PG8_SA(0, 0), cA, voffA); PG8_STAGE(PG8_SB(0, 1), cB + hstep, voffB); PG8_STAGE(PG8_SA(0, 1), cA + hstep, voffA);
    if (wr == 1) PG8_BAR;
    PG8_WAIT_V(4); PG8_BAR;
    PG8_STAGE(PG8_SB(1, 0), cB + kstep, voffB); PG8_STAGE(PG8_SA(1, 0), cA + kstep, voffA); PG8_STAGE(PG8_SB(1, 1), cB + hstep + kstep, voffB);
    PG8_WAIT_V(6); PG8_BAR;
    PG8_STAMP();
    for (;;) {
        const bool has_next = S.next(ui + 1, nxt);
        const char* nA = has_next ? (const char*)g.A + (size_t)nxt.pm * tstep : cA; const char* nB = has_next ? (const char*)g.Bt + (size_t)nxt.pn * tstep : cB;
        for (int t = 0; t < nt; t += 2) {
            const bool last = (t == nt - 2);
            const char* a1 = cA + (size_t)(t + 1) * kstep;
            const char* a2 = last ? nA : cA + (size_t)(t + 2) * kstep; const char* b2 = last ? nB : cB + (size_t)(t + 2) * kstep;
            const char* a3 = a2 + kstep; const char* b3 = b2 + kstep;
            if (last && has_next) S.a_ready(nxt);
            PG8_LDB(B0, 0, 0); PG8_SCHED; PG8_LDA(At, 0, 0); PG8_STAGE(PG8_SA(1, 1), a1 + hstep, voffA);
            PG8_WAIT_L(8); PG8_BAR; PG8_WAIT_L(0); PG8_MMA(0, 0, At, B0); PG8_BAR; PG8_SCHED;
            PG8_LDB(B1, 0, 1); PG8_STAGE(PG8_SB(0, 0), b2, voffB);
            PG8_BAR; PG8_WAIT_L(0); PG8_MMA(0, 1, At, B1); PG8_BAR;
            PG8_LDA(At, 0, 1); PG8_STAGE(PG8_SA(0, 0), a2, voffA);
            PG8_BAR; PG8_WAIT_L(0); PG8_MMA(1, 0, At, B0); PG8_BAR; PG8_SCHED;
            PG8_STAGE(PG8_SB(0, 1), b2 + hstep, voffB);
            PG8_WAIT_V(6); PG8_BAR; PG8_MMA(1, 1, At, B1); PG8_BAR;
            PG8_LDB(B0, 1, 0); PG8_SCHED; PG8_LDA(At, 1, 0); PG8_STAGE(PG8_SA(0, 1), a2 + hstep, voffA);
            PG8_WAIT_L(8); PG8_BAR; PG8_WAIT_L(0); PG8_MMA(0, 0, At, B0); PG8_BAR; PG8_SCHED;
            PG8_LDB(B1, 1, 1); PG8_STAGE(PG8_SB(1, 0), b3, voffB);
            PG8_BAR; PG8_WAIT_L(0); PG8_MMA(0, 1, At, B1); PG8_BAR;
            PG8_LDA(At, 1, 1); PG8_STAGE(PG8_SA(1, 0), a3, voffA);
            PG8_BAR; PG8_WAIT_L(0); PG8_MMA(1, 0, At, B0); PG8_BAR; PG8_SCHED;
            PG8_STAGE(PG8_SB(1, 1), b3 + hstep, voffB);
            PG8_WAIT_V(6); PG8_BAR; PG8_MMA(1, 1, At, B1); PG8_BAR;
        }
        PG8_STAMP();
        if constexpr (!Epi::AFTER_DRAIN) { E(acc, cur, wr, wc, fr, fq); S.done(cur); }
        PG8_STAMP();
        if (!has_next) break;
#pragma unroll
        for (int a = 0; a < 2; ++a)
#pragma unroll
            for (int b = 0; b < 2; ++b)
#pragma unroll
                for (int m = 0; m < 4; ++m)
#pragma unroll
                    for (int n = 0; n < 2; ++n) acc[a][b][m][n] = (f32x4){0.f, 0.f, 0.f, 0.f};
        cur = nxt; cA = nA; cB = nB; ++ui;
    }
    PG8_WAIT_V(0);
    if (wr == 0) PG8_BAR;
    PG8_BAR;
    if constexpr (Epi::AFTER_DRAIN) { E.fused(acc, cur, wr, wc, fr, fq, lds, wid, lane); S.done(cur); }
    PG8_STAMP();
    if (STAMP && wid == 0) { stamps[lane] = lane < nts ? (((unsigned long long)(unsigned)ts_hi << 32) | (unsigned)ts_lo) : 0ull;
        if (lane == 62) stamps[62] = rt_entry; if (lane == 63) stamps[63] = (unsigned long long)wall_clock64(); }
#undef PG8_STAMP
#undef PG8_SA
#undef PG8_SB
#undef PG8_STAGE
#undef PG8_LDA
#undef PG8_LDB
#undef PG8_MMA
#undef PG8_WAIT_V
#undef PG8_WAIT_L
#undef PG8_BAR
#undef PG8_SCHED
}
}

template <class F>
__device__ __forceinline__ void pg8_epi8(const pg8::f32x4 (&acc)[2][2][4][2], const pg8::Unit& u, int wr, int wc, int fr, int fq, F f) {
  const int row0 = u.pm * 256 + wr * 64 + fr, col0 = u.pn * 256 + wc * 32 + 8 * fq;
#pragma unroll
  for (int ai = 0; ai < 2; ++ai)
#pragma unroll
    for (int m = 0; m < 4; ++m)
#pragma unroll
      for (int bj = 0; bj < 2; ++bj) f(row0 + ai * 128 + m * 16, col0 + bj * 128, acc[ai][bj][m][0], acc[ai][bj][m][1]);
}
template <class F>
__device__ __forceinline__ void pg8_epi4(const pg8::f32x4 (&acc)[2][2][4][2], const pg8::Unit& u, int wr, int wc, int fr, int fq, F f) {
  const int row0 = u.pm * 256 + wr * 64 + fr, col0 = u.pn * 256 + wc * 32 + 4 * fq;
#pragma unroll
  for (int ai = 0; ai < 2; ++ai)
#pragma unroll
    for (int m = 0; m < 4; ++m)
#pragma unroll
      for (int bj = 0; bj < 2; ++bj)
#pragma unroll
        for (int n = 0; n < 2; ++n) f(row0 + ai * 128 + m * 16, col0 + bj * 128 + n * 16, acc[ai][bj][m][n]);
}
__device__ __forceinline__ pg8::u32x4 pk8_bf16(const pg8::f32x4 v0, const pg8::f32x4 v1) {
  pg8::u32x4 w;
  w.x = pg8::cvt_pk_bf16(v0[0], v0[1]); w.y = pg8::cvt_pk_bf16(v0[2], v0[3]);
  w.z = pg8::cvt_pk_bf16(v1[0], v1[1]); w.w = pg8::cvt_pk_bf16(v1[2], v1[3]);
  return w;
}
struct EpiProj {
  static constexpr bool PERM = true, AFTER_DRAIN = false;
  u16* FIN; f16* RW;
  __device__ __forceinline__ void operator()(const pg8::f32x4 (&acc)[2][2][4][2], const pg8::Unit& u, int wr, int wc, int fr, int fq) const {
    pg8_epi8(acc, u, wr, wc, fr, fq, [&](int row, int col, const pg8::f32x4 v0, const pg8::f32x4 v1) {
      if (col < 512) {
        *(pg8::u32x4*)(FIN + (size_t)row * 512 + col) = pk8_bf16(v0, v1);
      } else if (col < 2432) {
        f16x8 o;
#pragma unroll
        for (int j = 0; j < 4; ++j) { o[j] = f2h(v0[j]); o[4 + j] = f2h(v1[j]); }
        *(f16x8*)(RW + (size_t)row * 1920 + (col - 512)) = o;
      }
    });
  }
};
struct EpiSig {
  static constexpr bool PERM = true, AFTER_DRAIN = false;
  u16* SG;
  __device__ __forceinline__ void operator()(const pg8::f32x4 (&acc)[2][2][4][2], const pg8::Unit& u, int wr, int wc, int fr, int fq) const {
    pg8_epi8(acc, u, wr, wc, fr, fq, [&](int row, int col, pg8::f32x4 v0, pg8::f32x4 v1) {
#pragma unroll
      for (int j = 0; j < 4; ++j) { v0[j] = sigmoidf_(v0[j]); v1[j] = sigmoidf_(v1[j]); }
      *(pg8::u32x4*)(SG + (size_t)row * 2048 + col) = pk8_bf16(v0, v1);
    });
  }
};
struct EpiGate {
  static constexpr bool PERM = true, AFTER_DRAIN = false;
  u16* MG; const u16* SG; int sg_off; int add;
  __device__ __forceinline__ void operator()(const pg8::f32x4 (&acc)[2][2][4][2], const pg8::Unit& u, int wr, int wc, int fr, int fq) const {
    const int row0 = u.pm * 256 + wr * 64 + fr, col0 = u.pn * 256 + wc * 32 + 8 * fq;
#pragma unroll
    for (int ai = 0; ai < 2; ++ai) {
      u16x8 sv[4][2], ov[4][2];
#pragma unroll
      for (int m = 0; m < 4; ++m)
#pragma unroll
        for (int bj = 0; bj < 2; ++bj) {
          const int row = row0 + ai * 128 + m * 16, col = col0 + bj * 128;
          sv[m][bj] = *(const u16x8*)(SG + (size_t)row * 2048 + sg_off + col);
          if (add) ov[m][bj] = *(const u16x8*)(MG + (size_t)row * 1024 + col);
        }
#pragma unroll
      for (int m = 0; m < 4; ++m)
#pragma unroll
        for (int bj = 0; bj < 2; ++bj) {
          const int row = row0 + ai * 128 + m * 16, col = col0 + bj * 128;
          pg8::f32x4 v0 = acc[ai][bj][m][0], v1 = acc[ai][bj][m][1];
#pragma unroll
          for (int j = 0; j < 4; ++j) { v0[j] *= bf2f(sv[m][bj][j]); v1[j] *= bf2f(sv[m][bj][4 + j]); }
          if (add) {
#pragma unroll
            for (int j = 0; j < 4; ++j) { v0[j] += bf2f(ov[m][bj][j]); v1[j] += bf2f(ov[m][bj][4 + j]); }
          }
          *(pg8::u32x4*)(MG + (size_t)row * 1024 + col) = pk8_bf16(v0, v1);
        }
    }
  }
};
struct EpiResid {
  static constexpr bool PERM = false, AFTER_DRAIN = false;
  float* XL; float* XC; const float* MODg;
  const float* RL; const float* RC;
  __device__ __forceinline__ void operator()(const pg8::f32x4 (&acc)[2][2][4][2], const pg8::Unit& u, int wr, int wc, int fr, int fq) const {
    const int row0 = u.pm * 256 + wr * 64 + fr, col0 = u.pn * 256 + wc * 32 + 4 * fq;
    const bool lat = (u.pm * 256) < TL;
    const int rbase = lat ? row0 : (row0 - TL);
    const float* rd = lat ? RL : RC;
    float* wrp = lat ? XL : XC;
    const float* gp = MODg + (size_t)(lat ? ((u.pm * 256) >> 11) : 8) * 6144 + col0;
    pg8::f32x4 g[2][2];
#pragma unroll
    for (int bj = 0; bj < 2; ++bj)
#pragma unroll
      for (int n = 0; n < 2; ++n) g[bj][n] = *(const pg8::f32x4*)(gp + bj * 128 + n * 16);
#pragma unroll
    for (int ai = 0; ai < 2; ++ai) {
      pg8::f32x4 x[4][2][2];
#pragma unroll
      for (int m = 0; m < 4; ++m)
#pragma unroll
        for (int bj = 0; bj < 2; ++bj)
#pragma unroll
          for (int n = 0; n < 2; ++n)
            x[m][bj][n] = *(const pg8::f32x4*)(rd + (size_t)(rbase + ai * 128 + m * 16) * 1024 + col0 + bj * 128 + n * 16);
#pragma unroll
      for (int m = 0; m < 4; ++m)
#pragma unroll
        for (int bj = 0; bj < 2; ++bj)
#pragma unroll
          for (int n = 0; n < 2; ++n)
            *(pg8::f32x4*)(wrp + (size_t)(rbase + ai * 128 + m * 16) * 1024 + col0 + bj * 128 + n * 16) = x[m][bj][n] + g[bj][n] * acc[ai][bj][m][n];
    }
  }
};
struct EpiGateOut {
  static constexpr bool PERM = true, AFTER_DRAIN = false;
  u16* D; const float* MODg;
  __device__ __forceinline__ void operator()(const pg8::f32x4 (&acc)[2][2][4][2], const pg8::Unit& u, int wr, int wc, int fr, int fq) const {
    const int col0 = u.pn * 256 + wc * 32 + 8 * fq;
    const bool lat = (u.pm * 256) < TL;
    const float* gp = MODg + (size_t)(lat ? ((u.pm * 256) >> 11) : 8) * 6144 + col0;
    pg8::f32x4 g[2][2];
#pragma unroll
    for (int bj = 0; bj < 2; ++bj)
#pragma unroll
      for (int n = 0; n < 2; ++n) g[bj][n] = *(const pg8::f32x4*)(gp + bj * 128 + n * 4);
    pg8_epi8(acc, u, wr, wc, fr, fq, [&](int row, int col, pg8::f32x4 v0, pg8::f32x4 v1) {
      const int bj = ((col - u.pn * 256) >> 7) & 1;
      v0 *= g[bj][0]; v1 *= g[bj][1];
      *(pg8::u32x4*)(D + (size_t)row * 1024 + col) = pk8_bf16(v0, v1);
    });
  }
};
struct EpiRelu2 {
  static constexpr bool PERM = true, AFTER_DRAIN = false;
  u16* HID;
  __device__ __forceinline__ void operator()(const pg8::f32x4 (&acc)[2][2][4][2], const pg8::Unit& u, int wr, int wc, int fr, int fq) const {
    pg8_epi8(acc, u, wr, wc, fr, fq, [&](int row, int col, pg8::f32x4 v0, pg8::f32x4 v1) {
#pragma unroll
      for (int j = 0; j < 4; ++j) { const float a = fmaxf(v0[j], 0.f), b = fmaxf(v1[j], 0.f); v0[j] = a * a; v1[j] = b * b; }
      *(pg8::u32x4*)(HID + (size_t)row * 4096 + col) = pk8_bf16(v0, v1);
    });
  }
};

struct EpiDft {
  static constexpr bool PERM = true, AFTER_DRAIN = false;
  u16* FOUT; const u16* X1024;
  __device__ __forceinline__ void operator()(const pg8::f32x4 (&acc)[2][2][4][2], const pg8::Unit& u, int wr, int wc, int fr, int fq) const {
    pg8_epi8(acc, u, wr, wc, fr, fq, [&](int row, int col, pg8::f32x4 v0, pg8::f32x4 v1) {
      const float sc = 1.f / 512.f;
      const u16x8 xv = *(const u16x8*)(X1024 + col);
      const float sg = (row & 1) ? -1.f : 1.f;
#pragma unroll
      for (int j = 0; j < 4; ++j) { v0[j] += sg * bf2f(xv[j]); v1[j] += sg * bf2f(xv[4 + j]); }
      v0 *= sc; v1 *= sc;
      *(pg8::u32x4*)(FOUT + ((size_t)(col >> 9) * 2048 + row) * 512 + (col & 511)) = pk8_bf16(v0, v1);
    });
  }
};

template <class Epi>
__device__ __forceinline__ void pg8_run(char* lds, const u16* A, const u16* Bt, int M, int N, int K, const Epi& E) {
  pg8::Gemm g{A, Bt, M, N, K};
  pg8::StaticOrder S;
  S.init(M, N, (int)gridDim.x, BID());
  __syncthreads();
  pg8::gemm_phase<Epi, pg8::StaticOrder, false>((PG8_LAS unsigned char*)lds, g, S, E, nullptr);
  __syncthreads();
}

__device__ void proj_phase(const Params& p, const u16* H, char* lds) {
  EpiProj E{(u16*)(WS(p) + OFF_FIN), (f16*)(WS(p) + OFF_RW)};
  pg8_run(lds, H, (const u16*)(WS(p) + OFF_WTA + WO_IN), TA, 2560, 1024, E);
}

__device__ void dft1_phase(const Params& p, int l, char* lds) {
  const u16* FIN = (const u16*)(WS(p) + OFF_FIN);
  const u16* TW = (const u16*)(WS(p) + OFF_AR) + DM_TW;
  u16* UCS = (u16*)(WS(p) + OFF_EH);
  u16* UCSC = UCS + (size_t)32 * 256 * 2048;
  const int ntiles = 512 + (l == 0 ? 64 : 0);
  for (int tile = BID(); tile < ntiles; tile += gridDim.x) {
    const u16* bt;
    u16* o;
    int ldo;
    if (tile < 512) {
      const int bg = tile >> 4, nt = tile & 15, b = bg >> 2, g = bg & 3;
      bt = FIN + (size_t)(b * 2048 + nt * 128) * 512 + g * 128;
      o = UCS + (size_t)bg * 256 * 2048 + nt * 128;
      ldo = 2048;
    } else {
      const int t2 = tile - 512;
      const int bg = t2 >> 1, nt = t2 & 1, b = bg >> 2, g = bg & 3;
      bt = FIN + (size_t)(TL + b * 256 + nt * 128) * 512 + g * 128;
      o = UCSC + (size_t)bg * 256 * 256 + nt * 128;
      ldo = 256;
    }
    f32x4 acc[4][4];
    acc_zero(acc);
    gemm_loop(acc, TW, 128, bt, 512, 128, lds);
    if (tile < 512) {
      epi_apply(acc, lds, [&](int r, int c, float (&v)[8]) { *(u16x8*)(o + (size_t)(r & 127) * 4096 + (r >> 7) * 2048 + c) = pack_bf8(v); });
    } else {
      epi_apply(acc, lds, [&](int r, int c, float (&v)[8]) { *(u16x8*)(o + (size_t)r * ldo + c) = pack_bf8(v); });
    }
  }
}

__device__ void fold_phase(const Params& p) {
  const u16* UCS = (const u16*)(WS(p) + OFF_EH);
  u16* EO = (u16*)(WS(p) + OFF_EO);
  u16* X = (u16*)(WS(p) + OFF_X1024);
  const int lane = TID() & 63;
  const int gw = BID() * 8 + (TID() >> 6), nw_ = gridDim.x * 8;
  for (int it = gw; it < 4096 * 2; it += nw_) {
    const int n = it >> 1, ci = (it & 1) * 64 + lane;
    const u16* uc = UCS + (size_t)n * 4096;
    const u16* us = uc + 2048;
    const u16x8 cf = *(const u16x8*)(uc + ci * 8), sf = *(const u16x8*)(us + ci * 8);
    const u16x8 ca = *(const u16x8*)(uc + (255 - ci) * 8), sa = *(const u16x8*)(us + (255 - ci) * 8);
    const int cb = (ci == 0) ? 255 : (256 - ci);
    const u16x8 cbv = *(const u16x8*)(uc + cb * 8), sbv = *(const u16x8*)(us + cb * 8);
    float e[8], o[8];
#pragma unroll
    for (int j = 0; j < 8; ++j) {
      const float c = bf2f(cf[j]), sn = bf2f(sf[j]);
      const float cm = (j == 0) ? bf2f(cbv[0]) : bf2f(ca[8 - j]);
      const float sm = (j == 0) ? bf2f(sbv[0]) : bf2f(sa[8 - j]);
      e[j] = c + cm;
      o[j] = sn - sm;
    }
    if (ci == 0) { e[0] = bf2f(cf[0]); o[0] = 0.f; }
    *(u16x8*)(EO + (size_t)n * 2048 + ci * 8) = pack_bf8(e);
    *(u16x8*)(EO + (size_t)n * 2048 + 1024 + ci * 8) = pack_bf8(o);
    if (ci == 0) X[n] = uc[1024];
  }
}

__device__ void dft2_phase(const Params& p, int l, char* lds) {
  const u16* DM = (const u16*)(WS(p) + OFF_AR);
  const u16* UCS = (const u16*)(WS(p) + OFF_EH);
  const u16* UCSC = UCS + (size_t)32 * 256 * 2048;
  u16* FOUT = (u16*)(WS(p) + OFF_FIN);
  EpiDft E{FOUT, (const u16*)(WS(p) + OFF_X1024)};
  pg8_run(lds, DM, (const u16*)(WS(p) + OFF_EO), 2048, 4096, 2048, E);
  const int hb = BID() - 128;
  if (hb >= 0) {
    if (l == 0) {
      for (int t2 = hb; t2 < 32; t2 += 128) {
        const int b = t2 >> 2, g = t2 & 3;
        const u16* bt = UCSC + (size_t)((b * 4 + g) * 256) * 256;
        u16* o = FOUT + (size_t)(TL + b * 256) * 512 + g * 128;
        const float sc = 0.005524271728019903f;
        f32x4 acc[4][4];
        acc_zero(acc);
#pragma unroll 1
        for (int seg = 0; seg < 2; ++seg)
          gemm_loop(acc, seg == 0 ? DM + DM_CC : DM + DM_NSC, 256, bt + (size_t)seg * 128 * 256, 256, 256, lds);
        epi_apply(acc, lds, [&](int r, int c, float (&v)[8]) {
#pragma unroll
          for (int j = 0; j < 8; ++j) v[j] *= sc;
          *(u16x8*)(o + (size_t)r * 512 + c) = pack_bf8(v);
        });
      }
    }
    conv_phase(p, l, 1, lds, hb, 128);
  }
}

__device__ void lora_phase(const Params& p, int l, char* lds) {
  const u16* LORA = (const u16*)(WS(p) + OFF_LORA);
  const u16* WupT = (const u16*)(WS(p) + OFF_WTA + WO_WUP);
  const u16* AupT = (const u16*)(WS(p) + OFF_WTA + WO_AUP);
  constexpr int MT = TA / 256;
  constexpr int total = 4 * MT * 4;
  const int tid = TID();
  const int lane = tid & 63, wave = tid >> 6;
  const int wm = wave >> 1, wn = wave & 1;
  u16* s0 = (u16*)lds;
  const int lr = tid >> 3, lc = (tid & 7) * 8;
  const int wofa = lr * LDT + lc, wofb = 256 * LDT + wofa;
  const int arow = (wm * 64 + (lane & 15)) * LDT + (lane >> 4) * 8;
  const int brow = (wn * 64 + (lane & 15)) * LDT + (lane >> 4) * 8;
  const int G = (int)gridDim.x;
  int tile = BID();
  if (tile >= total) return;
  uint4 ra0, ra1, ra2, ra3, rb0, rb1;
#define LORA_LOAD(tl) do { const int wh_ = (tl) / (MT * 4), rm_ = (tl) % (MT * 4), mt_ = rm_ >> 2, nt_ = rm_ & 3; \
    const u16* ap_ = LORA + (size_t)mt_ * 256 * 256 + wh_ * 64 + (size_t)lr * 256 + lc; \
    const u16* bp_ = (wh_ < 2 ? WupT : AupT) + (size_t)(wh_ & 1) * 512 * 64 + (size_t)nt_ * 128 * 64 + (size_t)lr * 64 + lc; \
    ra0 = *(const uint4*)ap_; ra1 = *(const uint4*)(ap_ + 64 * 256); ra2 = *(const uint4*)(ap_ + 128 * 256); ra3 = *(const uint4*)(ap_ + 192 * 256); \
    rb0 = *(const uint4*)bp_; rb1 = *(const uint4*)(bp_ + 64 * 64); } while (0)
  LORA_LOAD(tile);
  for (; tile < total; tile += G) {
    const int which = tile / (MT * 4), rem = tile % (MT * 4), mt = rem >> 2, nt = rem & 3;
    const int d = which & 1;
    __syncthreads();
    *(uint4*)(s0 + wofa) = ra0;
    *(uint4*)(s0 + wofa + 64 * LDT) = ra1;
    *(uint4*)(s0 + wofa + 128 * LDT) = ra2;
    *(uint4*)(s0 + wofa + 192 * LDT) = ra3;
    *(uint4*)(s0 + wofb) = rb0;
    *(uint4*)(s0 + wofb + 64 * LDT) = rb1;
    __syncthreads();
    if (tile + G < total) LORA_LOAD(tile + G);
    f32x4 acc[4][4];
    acc_zero(acc);
    {
      const u16* sa = s0;
      const u16* sb = s0 + 256 * LDT;
#define MF(i, j, av, bv) acc[i][j] = __builtin_amdgcn_mfma_f32_16x16x32_bf16(av, bv, acc[i][j], 0, 0, 0)
#pragma unroll
      for (int ks = 0; ks < 2; ++ks) {
        const bf16x8 a0 = *(const bf16x8*)(sa + arow + ks * 32);
        const bf16x8 a1 = *(const bf16x8*)(sa + arow + 16 * LDT + ks * 32);
        const bf16x8 a2 = *(const bf16x8*)(sa + arow + 32 * LDT + ks * 32);
        const bf16x8 a3 = *(const bf16x8*)(sa + arow + 48 * LDT + ks * 32);
        const bf16x8 b0 = *(const bf16x8*)(sb + brow + ks * 32);
        const bf16x8 b1 = *(const bf16x8*)(sb + brow + 16 * LDT + ks * 32);
        const bf16x8 b2 = *(const bf16x8*)(sb + brow + 32 * LDT + ks * 32);
        const bf16x8 b3 = *(const bf16x8*)(sb + brow + 48 * LDT + ks * 32);
        MF(0, 0, a0, b0); MF(0, 1, a0, b1); MF(0, 2, a0, b2); MF(0, 3, a0, b3);
        MF(1, 0, a1, b0); MF(1, 1, a1, b1); MF(1, 2, a1, b2); MF(1, 3, a1, b3);
        MF(2, 0, a2, b0); MF(2, 1, a2, b1); MF(2, 2, a2, b2); MF(2, 3, a2, b3);
        MF(3, 0, a3, b0); MF(3, 1, a3, b1); MF(3, 2, a3, b2); MF(3, 3, a3, b3);
      }
#undef MF
    }
    __syncthreads();
    f16* o = (f16*)(WS(p) + (which < 2 ? OFF_EH : OFF_AR)) + (size_t)d * TA * 512 + (size_t)mt * 256 * 512 + nt * 128;
    const float* bias = (which < 2 ? p.w0 : p.a0) + (size_t)l * 1024 + d * 512 + nt * 128;
    const float mul = (which < 2) ? 0.6065306597126334f : 1.f;
    epi_apply(acc, lds, [&](int r, int c, float (&v)[8]) {
      const float4 b0 = *(const float4*)(bias + c), b1 = *(const float4*)(bias + c + 4);
      const float bb[8] = {b0.x, b0.y, b0.z, b0.w, b1.x, b1.y, b1.z, b1.w};
#pragma unroll
      for (int j = 0; j < 8; ++j) v[j] = sigmoidf_(bb[j] + v[j]) * mul;
      *(f16x8*)(o + (size_t)r * 512 + c) = pack_h8(v);
    });
  }
#undef LORA_LOAD
  __syncthreads();
}

__device__ void g_phase(const Params& p, int ntok, char* lds) {
  const u16* GDS = (const u16*)(WS(p) + OFF_GDS);
  const u16* GupT = (const u16*)(WS(p) + OFF_WTA + WO_GUP);
  u16* Z = (u16*)(WS(p) + OFF_YS0);
  const int MT = ntok / 256;
  for (int tile = BID(); tile < MT * 4; tile += gridDim.x) {
    const int mt = tile >> 2, nt = tile & 3;
    f32x4 acc[4][4];
    acc_zero(acc);
    gemm_loop(acc, GDS + (size_t)mt * 256 * 128, 128, GupT + (size_t)nt * 128 * 128, 128, 128, lds);
    u16* o = Z + (size_t)mt * 256 * 512 + nt * 128;
    epi_apply(acc, lds, [&](int r, int c, float (&v)[8]) {
      u16x8* q = (u16x8*)(o + (size_t)r * 512 + c);
      const u16x8 z = *q;
#pragma unroll
      for (int j = 0; j < 8; ++j) v[j] *= bf2f(z[j]);
      *q = pack_bf8(v);
    });
  }
}

__device__ void gates_phase(const Params& p, const u16* H, int ntok, char* lds) {
  EpiSig E{(u16*)(WS(p) + OFF_YS1)};
  pg8_run(lds, H, (const u16*)(WS(p) + OFF_WTA + WO_IN) + (size_t)2432 * 1024, ntok, 2048, 1024, E);
}
__device__ void merge_phase(const Params& p, int ntok, char* lds) {
  u16* MG = (u16*)(WS(p) + OFF_AR);
  const u16* SG = (const u16*)(WS(p) + OFF_YS1);
  EpiGate E0{MG, SG, 0, 0};
  pg8_run(lds, (const u16*)(WS(p) + OFF_FIN), (const u16*)(WS(p) + OFF_WTA + WO_FU), ntok, 1024, 512, E0);
  EpiGate E1{MG, SG, 1024, 1};
  pg8_run(lds, (const u16*)(WS(p) + OFF_YS0), (const u16*)(WS(p) + OFF_WTA + WO_RU), ntok, 1024, 512, E1);
}
__device__ void resid_gemm_phase(const Params& p, int l, int ntok, const u16* A, int K, const u16* Bt, int gate_off, bool from_inputs, char* lds) {
  float* XC = (float*)(WS(p) + OFF_XC);
  EpiResid E{p.out, XC, (const float*)(WS(p) + OFF_MOD) + (size_t)l * 9 * 6144 + gate_off,
             from_inputs ? p.x : (const float*)p.out, from_inputs ? p.ctx : (const float*)XC};
  pg8_run(lds, A, Bt, ntok, 1024, K, E);
}

__device__ void mlp_down_ctx_phase(const Params& p, char* lds) {
  const u16* HID = (const u16*)(WS(p) + OFF_HID) + (size_t)TL * 4096;
  const u16* W2T = (const u16*)(WS(p) + OFF_W2T);
  u16* PART = (u16*)(WS(p) + OFF_FIN);
  for (int item = BID(); item < 256; item += gridDim.x) {
    const int ks = item & 3, nt = (item >> 2) & 7, mt = item >> 5;
    f32x4 acc[4][4];
    acc_zero(acc);
    gemm_loop(acc, HID + (size_t)mt * 256 * 4096 + ks * 1024, 4096, W2T + (size_t)nt * 128 * 4096 + ks * 1024, 4096, 1024, lds);
    u16* o = PART + ((size_t)ks * 2048 + mt * 256) * 1024 + nt * 128;
    epi_apply(acc, lds, [&](int r, int c, float (&v)[8]) { *(u16x8*)(o + (size_t)r * 1024 + c) = pack_bf8(v); });
  }
}

__device__ void out_ctx_phase(const Params& p, char* lds) {
  const u16* MG = (const u16*)(WS(p) + OFF_AR) + (size_t)TL * 1024;
  const u16* WoutT = (const u16*)(WS(p) + OFF_WTA + WO_OUT);
  u16* PART = (u16*)(WS(p) + OFF_FIN);
  const float* g1 = (const float*)(WS(p) + OFF_MOD) + (size_t)8 * 6144 + 2048;
  for (int item = BID(); item < 256; item += gridDim.x) {
    const int ks = item & 3, nt = (item >> 2) & 7, mt = item >> 5;
    f32x4 acc[4][4];
    acc_zero(acc);
    gemm_loop(acc, MG + (size_t)mt * 256 * 1024 + ks * 256, 1024, WoutT + (size_t)nt * 128 * 1024 + ks * 256, 1024, 256, lds);
    u16* o = PART + ((size_t)ks * 2048 + mt * 256) * 1024 + nt * 128;
    const float* gg = g1 + nt * 128;
    epi_apply(acc, lds, [&](int r, int c, float (&v)[8]) {
      const float4 ga = *(const float4*)(gg + c), gb = *(const float4*)(gg + c + 4);
      v[0] *= ga.x; v[1] *= ga.y; v[2] *= ga.z; v[3] *= ga.w; v[4] *= gb.x; v[5] *= gb.y; v[6] *= gb.z; v[7] *= gb.w;
      *(u16x8*)(o + (size_t)r * 1024 + c) = pack_bf8(v);
    });
  }
}

__device__ void mlp_up_phase(const Params& p, int ntok, char* lds) {
  EpiRelu2 E{(u16*)(WS(p) + OFF_HID)};
  pg8_run(lds, (const u16*)(WS(p) + OFF_EH), (const u16*)(WS(p) + OFF_W1T), ntok, 4096, 1024, E);
}

#define XB_TMO      128
#define XB_XCNT(j)  (256  + 64 * (j))
#define XB_XSUB(j)  (1280 + 64 * (j))
#define XB_XGEN(j)  (2304 + 64 * (j))
#define XB_TOP      3328
#define XB_TOPGEN   3392
#define XCD_BAR_WORDS 3456
#define XB_SPIN_CAP (1u << 18)
#define LAS __attribute__((address_space(3)))

__device__ __forceinline__ unsigned xb_ld(unsigned* p)              { return __hip_atomic_load(p, __ATOMIC_RELAXED, __HIP_MEMORY_SCOPE_AGENT); }
__device__ __forceinline__ unsigned xb_add(unsigned* p, unsigned v) { return __hip_atomic_fetch_add(p, v, __ATOMIC_RELAXED, __HIP_MEMORY_SCOPE_AGENT); }
__device__ __forceinline__ unsigned xb_xcc_id() { return (unsigned)__builtin_amdgcn_s_getreg((3 << 11) | 20) & 0xFu; }
#define XB_SPIN(cond, bar) do { unsigned _sp = 0; while (cond) { __builtin_amdgcn_s_sleep(1); \
    if ((++_sp & 255u) == 0u) { if (xb_ld(&(bar)[XB_TMO])) break; if (_sp > XB_SPIN_CAP) { atomicAdd(&(bar)[XB_TMO], 1u); break; } } } } while (0)

struct XcdBarrier { unsigned* bar; unsigned x; volatile LAS unsigned* st; };

__device__ __forceinline__ XcdBarrier xcd_barrier_post(unsigned* bar, volatile LAS unsigned* st) {
    XcdBarrier b; b.bar = bar; b.x = xb_xcc_id(); b.st = st;
    if (threadIdx.x == 0) (void)xb_add(&bar[XB_XCNT(b.x)], 1u);
    return b;
}
__device__ __forceinline__ void xcd_barrier_complete(unsigned* bar, unsigned x, unsigned& nloc, unsigned& nx) {
    const unsigned G = gridDim.x * gridDim.y * gridDim.z;
    unsigned sum, cnt, mine, sp = 0u;
    for (;;) {
        sum = 0u; cnt = 0u; mine = 0u;
#pragma unroll
        for (unsigned j = 0; j < 16; ++j) { const unsigned c = xb_ld(&bar[XB_XCNT(j)]); sum += c; cnt += (c > 0u) ? 1u : 0u; mine = (j == x) ? c : mine; }
        if (sum == G) break;
        __builtin_amdgcn_s_sleep(1);
        if ((++sp & 255u) == 0u) { if (xb_ld(&bar[XB_TMO])) break; if (sp > XB_SPIN_CAP) { atomicAdd(&bar[XB_TMO], 1u); break; } }
    }
    nloc = mine > 0u ? mine : 1u; nx = cnt > 0u ? cnt : 1u;
}
__device__ __forceinline__ void xcd_barrier(const XcdBarrier& b) {
    asm volatile("s_waitcnt vmcnt(0)" ::: "memory");
    __syncthreads();
    if (threadIdx.x == 0) {
        int bz = 0; asm volatile("" : "+s"(bz));
        unsigned* bar = b.bar + bz;
        __builtin_amdgcn_s_waitcnt(0);
        unsigned nloc = b.st[0], nx = b.st[1];
        if (nloc == 0u) { xcd_barrier_complete(bar, b.x, nloc, nx); b.st[0] = nloc; b.st[1] = nx; }
        const unsigned old = xb_add(&bar[XB_XSUB(b.x)], 1u);
        const unsigned gen = old / nloc;
        if (old + 1u == (gen + 1u) * nloc) {
            __builtin_amdgcn_fence(__ATOMIC_RELEASE, "agent");
            asm volatile("s_waitcnt vmcnt(0)" ::: "memory");
            const unsigned og = xb_add(&bar[XB_TOP], 1u);
            const unsigned tg = og / nx;
            if (og + 1u == (tg + 1u) * nx) xb_add(&bar[XB_TOPGEN], 1u);
            else XB_SPIN(xb_ld(&bar[XB_TOPGEN]) == tg, bar);
            __builtin_amdgcn_fence(__ATOMIC_ACQUIRE, "agent");
            xb_add(&bar[XB_XGEN(b.x)], 1u);
            asm volatile("s_waitcnt vmcnt(0)" ::: "memory");
        } else {
            XB_SPIN(xb_ld(&bar[XB_XGEN(b.x)]) == gen, bar);
            __builtin_amdgcn_fence(__ATOMIC_ACQUIRE, "agent");
            asm volatile("s_waitcnt vmcnt(0)" ::: "memory");
        }
    }
    __syncthreads();
}

constexpr int PH_PER_LAYER = 14;
constexpr int N_PHASES = 1 + 2 * PH_PER_LAYER + 1;

typedef const __attribute__((address_space(4))) Params* KParamsPtr;
__device__ __forceinline__ void run_phase(int ph, char* lds) {
#if defined(__HIP_DEVICE_COMPILE__)
  int kz = 0; asm volatile("" : "+s"(kz));
  const Params p = *(KParamsPtr)((const __attribute__((address_space(4))) char*)__builtin_amdgcn_kernarg_segment_ptr() + kz);
#else
  const Params p{};
#endif
  if (ph == 0) {
    mod_phase(p, lds);
    return;
  }
  if (ph == N_PHASES - 1) { final_norm(p); return; }
  const int l = (ph - 1) / PH_PER_LAYER, q = (ph - 1) % PH_PER_LAYER;
  const int ntok = (l == 0) ? TA : TL;
  u16* Hbuf = (l == 0) ? (u16*)p.out : (u16*)(WS(p) + OFF_EH);
  switch (q) {
    case 0:
      conv_phase(p, l, 0, lds);
      dftm_gen(p, lds);
      normmod_phase(p, l, 0, TA, Hbuf, l == 0, nullptr, (l == 1) ? (const u16*)(WS(p) + OFF_FIN) : nullptr,
                    (const float*)(WS(p) + OFF_MOD) + (size_t)8 * 6144 + 5120);
      break;
    case 1: proj_phase(p, Hbuf, lds); break;
    case 2: dft1_phase(p, l, lds); prep3a_phase(p, l); break;
    case 3: fold_phase(p); break;
    case 4: dft2_phase(p, l, lds); break;
    case 5: lora_phase(p, l, lds); break;
    case 6: scan_phase(p, l, lds); break;
    case 7:
      post5a_phase(p, l, ntok);
      if (l != 0) normmod_phase(p, l, 0, ntok, Hbuf, false);
      break;
    case 8: g_phase(p, ntok, lds); gates_phase(p, Hbuf, ntok, lds); break;
    case 9: merge_phase(p, ntok, lds); break;
    case 10: {
      EpiGateOut E{(u16*)(WS(p) + OFF_YS1), (const float*)(WS(p) + OFF_MOD) + (size_t)l * 9 * 6144 + 2048};
      if (l == 0) out_ctx_phase(p, lds);
      pg8_run(lds, (const u16*)(WS(p) + OFF_AR), (const u16*)(WS(p) + OFF_WTA + WO_OUT), TL, 1024, 1024, E);
    } break;
    case 11: normmod_phase(p, l, 1, ntok, (u16*)(WS(p) + OFF_EH), l == 0, (const u16*)(WS(p) + OFF_YS1),
                           (l == 0) ? (const u16*)(WS(p) + OFF_FIN) : nullptr); break;
    case 12: mlp_up_phase(p, ntok, lds); break;
    case 13:
      if (l == 0) {
        mlp_down_ctx_phase(p, lds);
        resid_gemm_phase(p, l, TL, (const u16*)(WS(p) + OFF_HID), 4096, (const u16*)(WS(p) + OFF_W2T), 5120, false, lds);
      } else {
        EpiGateOut E{(u16*)(WS(p) + OFF_EH), (const float*)(WS(p) + OFF_MOD) + (size_t)l * 9 * 6144 + 5120};
        pg8_run(lds, (const u16*)(WS(p) + OFF_HID), (const u16*)(WS(p) + OFF_W2T), TL, 1024, 4096, E);
      }
      break;
  }
}

extern "C" __global__ void __launch_bounds__(NTHREADS) fwd_megakernel(Params p) {
  extern __shared__ __attribute__((aligned(16))) char lds[];
#if ONE_LAUNCH
  cg::grid_group grid = cg::this_grid();
  if (threadIdx.x == 0) *(uint4*)(lds + LDS_STAGE_BYTES) = make_uint4(0u, 0u, 0u, 0u);
  __syncthreads();
  XcdBarrier xb = xcd_barrier_post((unsigned*)(p.ws + OFF_BAR), (volatile LAS unsigned*)(lds + LDS_STAGE_BYTES));
#ifndef REP_MASK
#define REP_MASK 0
#endif
  int ph = p.ph_lo, rep = 0;
  while (ph < p.ph_hi) {
    run_phase(ph, lds);
    const bool first = (ph == p.ph_lo) && (rep == 0);
    const bool again = (rep == 0) && ph >= 1 && ph < N_PHASES - 1 && ((REP_MASK >> ((ph - 1) % PH_PER_LAYER)) & 1);
    if (again) rep = 1; else { rep = 0; ++ph; }
    if (ph < p.ph_hi) {
      if (first && p.ph_hi < 0) grid.sync();
      else xcd_barrier(xb);
    }
  }
#else
  for (int ph = p.ph_lo; ph < p.ph_hi; ++ph) run_phase(ph, lds);
#endif
}

extern "C" void kernel_launch(void* const* d_in, const int* in_sizes, int n_in, void* d_out, int out_size, void* d_ws,
                              size_t ws_size, hipStream_t stream) {
  static int grid = 0;
  if (grid == 0) {
    if (ws_size < WS_NEED) { fprintf(stderr, "kernel_launch: workspace too small: %zu < %zu\n", ws_size, (size_t)WS_NEED); grid = -1; return; }
    int dev = 0, cus = 0, per_cu = 0;
    hipGetDevice(&dev);
    hipDeviceGetAttribute(&cus, hipDeviceAttributeMultiprocessorCount, dev);
    hipFuncSetAttribute((const void*)fwd_megakernel, hipFuncAttributeMaxDynamicSharedMemorySize, LDS_BYTES);
    hipOccupancyMaxActiveBlocksPerMultiprocessor(&per_cu, (const void*)fwd_megakernel, NTHREADS, LDS_BYTES);
    if (per_cu < 1) per_cu = 1;
    grid = cus;
    (void)hipGetLastError();
  }
  if (grid < 0) return;
  Params p{};
  const float** pp = (const float**)&p;
  for (int i = 0; i < 26; ++i) pp[i] = (const float*)d_in[i];
  p.out = (float*)d_out;
  p.ws = (char*)d_ws;
#if ONE_LAUNCH
  (void)hipMemsetAsync((char*)d_ws + OFF_BAR, 0, XCD_BAR_WORDS * sizeof(unsigned), stream);
  p.ph_lo = 0; p.ph_hi = N_PHASES;
  void* args[] = {&p};
  hipError_t e = hipLaunchCooperativeKernel((const void*)fwd_megakernel, dim3(grid), dim3(NTHREADS), args, LDS_BYTES, stream);
  if (e != hipSuccess) fprintf(stderr, "cooperative launch failed: %s (grid %d)\n", hipGetErrorString(e), grid);
#else
  for (int ph = 0; ph < N_PHASES; ++ph) {
    p.ph_lo = ph; p.ph_hi = ph + 1;
    hipLaunchKernelGGL(fwd_megakernel, dim3(grid), dim3(NTHREADS), LDS_BYTES, stream, p);
  }
#endif
}
```

```cpp
#include <hip/hip_runtime.h>
#include <hip/hip_cooperative_groups.h>
#include <cstdio>
#include <cstdint>
#include <cstddef>
namespace cg = cooperative_groups;

typedef unsigned short u16;
typedef _Float16 f16;
using bf16x8 = __attribute__((ext_vector_type(8))) short;
using f32x4 = __attribute__((ext_vector_type(4))) float;
using f32x2 = __attribute__((ext_vector_type(2))) float;
using f16x8 = __attribute__((ext_vector_type(8))) _Float16;
using f16x4 = __attribute__((ext_vector_type(4))) _Float16;
using u16x8 = __attribute__((ext_vector_type(8))) unsigned short;

#ifndef ONE_LAUNCH
#define ONE_LAUNCH 1
#endif

constexpr int D = 1024, NB = 8, L = 2048, LC = 256, TL = 16384, TC = 2048, TA = 18432;
constexpr int NTHREADS = 512;
constexpr int LDT = 72;
constexpr int STAGE_ELEMS = (256 + 128) * LDT;
constexpr int LDS_STAGE_BYTES = 131072;
constexpr int LDS_BYTES = LDS_STAGE_BYTES + 16;

constexpr size_t MiB = (size_t)1 << 20;
constexpr size_t OFF_MOD = 0;
constexpr size_t OFF_XC = 1 * MiB;
constexpr size_t OFF_WTA = 9 * MiB;
constexpr size_t OFF_FIN = 23 * MiB;
constexpr size_t OFF_EH = 41 * MiB;
constexpr size_t OFF_RW = 77 * MiB;
constexpr size_t OFF_W1T = 77 * MiB;
constexpr size_t OFF_W2T = 85 * MiB;
constexpr size_t OFF_YS0 = 93 * MiB;
constexpr size_t OFF_YS1 = 111 * MiB;
constexpr size_t OFF_HID = 93 * MiB;
constexpr size_t OFF_R = 144 * MiB + MiB / 2;
constexpr size_t OFF_K = OFF_R + 18 * MiB;
constexpr size_t OFF_V = OFF_K + 18 * MiB;
constexpr size_t OFF_AR = OFF_V + 18 * MiB;
constexpr size_t OFF_LORA = OFF_AR + 36 * MiB;
constexpr size_t OFF_GDS = OFF_LORA + 9 * MiB;
constexpr size_t OFF_INVN = OFF_GDS + 4 * MiB + MiB / 2;
constexpr size_t OFF_EO = OFF_YS0;
constexpr size_t OFF_X1024 = OFF_YS0 + 16 * MiB;
constexpr size_t OFF_BAR = 250 * MiB;
constexpr size_t WS_NEED = OFF_BAR + MiB;
constexpr size_t WO_IN = 0, WO_FU = 9175040, WO_RU = 10223616, WO_OUT = 11272192, WO_WUP = 13369344, WO_AUP = 13500416, WO_GUP = 13631488;
constexpr size_t DM_C = 0, DM_NS = (size_t)2048 * 2048, DM_CC = (size_t)2 * 2048 * 2048, DM_NSC = DM_CC + 65536, DM_TW = DM_NSC + 65536;

struct Params {
  const float *x, *c, *ctx, *c_ctx, *w_mod, *b_mod, *norm1, *norm2, *w_in, *mu_shift, *w0, *w_up, *a0, *a_up, *g_up,
      *k_k, *k_a, *r_k, *ln_x_w, *ln_x_b, *w_fourier_up, *w_rwkv_up, *w_out, *mlp_w1, *mlp_w2, *norm_f;
  float* out;
  char* ws;
  int ph_lo, ph_hi;
};
__device__ __forceinline__ char* WS(const Params& p) { int z = 0; asm volatile("" : "+s"(z)); return p.ws + z; }


__device__ __forceinline__ int TID() { int t = threadIdx.x; asm volatile("" : "+v"(t)); return t; }
__device__ __forceinline__ int BID() { int t = blockIdx.x; asm volatile("" : "+s"(t)); return t; }
__device__ __forceinline__ u16 f2bf(float f) {
  uint32_t u = __float_as_uint(f);
  u += 0x7fffu + ((u >> 16) & 1u);
  return (u16)(u >> 16);
}
__device__ __forceinline__ float bf2f(u16 h) { return __uint_as_float(((uint32_t)h) << 16); }
__device__ __forceinline__ float sigmoidf_(float x) { return __builtin_amdgcn_exp2f(-__builtin_amdgcn_logf(1.f + __expf(-x))); }
__device__ __forceinline__ f16 f2h(float v) { v = fminf(fmaxf(v, -60000.f), 60000.f); return (f16)v; }

template <int CTRL>
__device__ __forceinline__ float dpp_f(float x) {
  return __int_as_float(__builtin_amdgcn_update_dpp(0, __float_as_int(x), CTRL, 0xf, 0xf, true));
}
__device__ __forceinline__ float red8(float x) {
  x += dpp_f<0xB1>(x);
  x += dpp_f<0x4E>(x);
  x += dpp_f<0x141>(x);
  return x;
}
__device__ __forceinline__ float wave_sum(float v) {
#pragma unroll
  for (int o = 32; o > 0; o >>= 1) v += __shfl_xor(v, o, 64);
  return v;
}

__device__ __forceinline__ void gemm_loop(f32x4 (&acc)[4][4], const u16* __restrict__ A, int lda,
                                          const u16* __restrict__ Bt, int ldb, int K, char* lds) {
  const int tid = TID();
  const int lane = tid & 63, wave = tid >> 6;
  const int wm = wave >> 1, wn = wave & 1;
  u16* s0 = (u16*)lds;
  const int lr = tid >> 3, lc = (tid & 7) * 8;
  const u16* ap0 = A + (size_t)lr * lda + lc;
  const u16* ap1 = ap0 + (size_t)64 * lda;
  const u16* ap2 = ap0 + (size_t)128 * lda;
  const u16* ap3 = ap0 + (size_t)192 * lda;
  const u16* bp0 = Bt + (size_t)lr * ldb + lc;
  const u16* bp1 = bp0 + (size_t)64 * ldb;
  const int KT = K >> 6;
  const int wofa = lr * LDT + lc;
  const int wofb = 256 * LDT + wofa;
  const int arow = (wm * 64 + (lane & 15)) * LDT + (lane >> 4) * 8;
  const int brow = (wn * 64 + (lane & 15)) * LDT + (lane >> 4) * 8;
#define G_LOAD(S, kt_) do { const int ko_ = (kt_) * 64; \
    S##a0 = *(const uint4*)(ap0 + ko_); S##a1 = *(const uint4*)(ap1 + ko_); S##a2 = *(const uint4*)(ap2 + ko_); S##a3 = *(const uint4*)(ap3 + ko_); \
    S##b0 = *(const uint4*)(bp0 + ko_); S##b1 = *(const uint4*)(bp1 + ko_); } while (0)
#define G_WRITE(S, st_) do { u16* w_ = s0 + (st_) * STAGE_ELEMS; \
    *(uint4*)(w_ + wofa) = S##a0; *(uint4*)(w_ + wofa + 64 * LDT) = S##a1; *(uint4*)(w_ + wofa + 128 * LDT) = S##a2; *(uint4*)(w_ + wofa + 192 * LDT) = S##a3; \
    *(uint4*)(w_ + wofb) = S##b0; *(uint4*)(w_ + wofb + 64 * LDT) = S##b1; } while (0)
#define MF(i, j, av, bv) acc[i][j] = __builtin_amdgcn_mfma_f32_16x16x32_bf16(av, bv, acc[i][j], 0, 0, 0)
#define G_COMPUTE(st_) do { const u16* sa = s0 + (st_) * STAGE_ELEMS; const u16* sb = sa + 256 * LDT; \
    _Pragma("unroll") for (int ks = 0; ks < 2; ++ks) { \
      const bf16x8 a0 = *(const bf16x8*)(sa + arow + ks * 32); \
      const bf16x8 a1 = *(const bf16x8*)(sa + arow + 16 * LDT + ks * 32); \
      const bf16x8 a2 = *(const bf16x8*)(sa + arow + 32 * LDT + ks * 32); \
      const bf16x8 a3 = *(const bf16x8*)(sa + arow + 48 * LDT + ks * 32); \
      const bf16x8 b0 = *(const bf16x8*)(sb + brow + ks * 32); \
      const bf16x8 b1 = *(const bf16x8*)(sb + brow + 16 * LDT + ks * 32); \
      const bf16x8 b2 = *(const bf16x8*)(sb + brow + 32 * LDT + ks * 32); \
      const bf16x8 b3 = *(const bf16x8*)(sb + brow + 48 * LDT + ks * 32); \
      MF(0, 0, a0, b0); MF(0, 1, a0, b1); MF(0, 2, a0, b2); MF(0, 3, a0, b3); \
      MF(1, 0, a1, b0); MF(1, 1, a1, b1); MF(1, 2, a1, b2); MF(1, 3, a1, b3); \
      MF(2, 0, a2, b0); MF(2, 1, a2, b1); MF(2, 2, a2, b2); MF(2, 3, a2, b3); \
      MF(3, 0, a3, b0); MF(3, 1, a3, b1); MF(3, 2, a3, b2); MF(3, 3, a3, b3); } } while (0)
  uint4 Pa0, Pa1, Pa2, Pa3, Pb0, Pb1, Qa0, Qa1, Qa2, Qa3, Qb0, Qb1;
  __syncthreads();
  G_LOAD(P, 0);
  G_WRITE(P, 0);
  if (KT == 1) {
    __syncthreads();
    G_COMPUTE(0);
    __syncthreads();
  } else if (KT == 2) {
    G_LOAD(P, 1);
    __syncthreads();
    G_COMPUTE(0);
    G_WRITE(P, 1);
    __syncthreads();
    G_COMPUTE(1);
    __syncthreads();
  } else {
    G_LOAD(P, 1);
    G_LOAD(Q, 2);
    __syncthreads();
    int kt = 0;
    for (; kt + 4 < KT; kt += 2) {
      G_COMPUTE(0);
      G_WRITE(P, 1);
      G_LOAD(P, kt + 3);
      __syncthreads();
      G_COMPUTE(1);
      G_WRITE(Q, 0);
      G_LOAD(Q, kt + 4);
      __syncthreads();
    }
    G_COMPUTE(0);
    G_WRITE(P, 1);
    G_LOAD(P, kt + 3);
    __syncthreads();
    G_COMPUTE(1);
    G_WRITE(Q, 0);
    __syncthreads();
    G_COMPUTE(0);
    G_WRITE(P, 1);
    __syncthreads();
    G_COMPUTE(1);
    __syncthreads();
  }
#undef G_LOAD
#undef G_WRITE
#undef G_COMPUTE
#undef MF
}

__device__ __forceinline__ void acc_zero(f32x4 (&acc)[4][4]) {
#pragma unroll
  for (int i = 0; i < 4; ++i)
#pragma unroll
    for (int j = 0; j < 4; ++j) acc[i][j] = f32x4{0.f, 0.f, 0.f, 0.f};
}

template <class F>
__device__ __forceinline__ void epi_apply(f32x4 (&acc)[4][4], char* lds, F f) {
  const int lane = TID() & 63, wave = TID() >> 6;
  const int wm = wave >> 1, wn = wave & 1;
  float* sw = (float*)lds + wave * (32 * 68);
#pragma unroll
  for (int hp = 0; hp < 2; ++hp) {
#pragma unroll
    for (int m2 = 0; m2 < 2; ++m2)
#pragma unroll
      for (int nf = 0; nf < 4; ++nf)
#pragma unroll
        for (int r = 0; r < 4; ++r)
          sw[(m2 * 16 + (lane >> 4) * 4 + r) * 68 + nf * 16 + (lane & 15)] = acc[hp * 2 + m2][nf][r];
    __builtin_amdgcn_wave_barrier();
#pragma unroll
    for (int i = 0; i < 4; ++i) {
      const int rr = i * 8 + (lane >> 3), cc = (lane & 7) * 8;
      const float4 a = *(const float4*)(sw + rr * 68 + cc), b = *(const float4*)(sw + rr * 68 + cc + 4);
      float v[8] = {a.x, a.y, a.z, a.w, b.x, b.y, b.z, b.w};
      f(wm * 64 + hp * 32 + rr, wn * 64 + cc, v);
    }
    __builtin_amdgcn_wave_barrier();
  }
}

__device__ __forceinline__ u16x8 pack_bf8(const float (&v)[8]) {
  u16x8 o;
#pragma unroll
  for (int j = 0; j < 8; ++j) o[j] = f2bf(v[j]);
  return o;
}
__device__ __forceinline__ f16x8 pack_h8(const float (&v)[8]) {
  f16x8 o;
#pragma unroll
  for (int j = 0; j < 8; ++j) o[j] = f2h(v[j]);
  return o;
}

__device__ void copy_f4(const float* __restrict__ src, float* __restrict__ dst, size_t n4) {
  const float4* s = (const float4*)src; float4* d = (float4*)dst;
  for (size_t i = (size_t)BID() * NTHREADS + TID(); i < n4; i += (size_t)gridDim.x * NTHREADS) d[i] = s[i];
}

__device__ void mod_phase(const Params& p, char* lds) {
  float* sl = (float*)lds;
  float* red = sl + 9 * 1024;
  float* MOD = (float*)(WS(p) + OFF_MOD);
  const int tid = TID(), lane = tid & 63, wave = tid >> 6;
  __syncthreads();
  for (int i = tid; i < 9 * 1024; i += NTHREADS) {
    float v = (i < 8 * 1024) ? p.c[i] : p.c_ctx[i - 8 * 1024];
    sl[i] = v * sigmoidf_(v);
  }
  __syncthreads();
  for (int item = BID(); item < 192; item += gridDim.x) {
    const int l = item / 96, n0 = (item % 96) * 64;
    const float* w = p.w_mod + (size_t)l * 1024 * 6144 + n0 + lane;
    float acc[9];
#pragma unroll
    for (int r = 0; r < 9; ++r) acc[r] = 0.f;
    const int kbeg = wave * 128;
#pragma unroll 1
    for (int kb = kbeg; kb < kbeg + 128; kb += 32) {
      float wv[32];
#pragma unroll
      for (int i = 0; i < 32; ++i) wv[i] = w[(size_t)(kb + i) * 6144];
#pragma unroll
      for (int i4 = 0; i4 < 8; ++i4) {
#pragma unroll
        for (int r = 0; r < 9; ++r) {
          const float4 s4 = *(const float4*)(sl + r * 1024 + kb + i4 * 4);
          acc[r] += s4.x * wv[i4 * 4] + s4.y * wv[i4 * 4 + 1] + s4.z * wv[i4 * 4 + 2] + s4.w * wv[i4 * 4 + 3];
        }
      }
    }
#pragma unroll
    for (int r = 0; r < 9; ++r) red[(wave * 9 + r) * 64 + lane] = acc[r];
    __syncthreads();
    for (int i = tid; i < 9 * 64; i += NTHREADS) {
      int r = i >> 6, ln = i & 63;
      float s = 0.f;
#pragma unroll
      for (int w8 = 0; w8 < 8; ++w8) s += red[(w8 * 9 + r) * 64 + ln];
      MOD[((size_t)l * 9 + r) * 6144 + n0 + ln] = s + p.b_mod[(size_t)l * 6144 + n0 + ln];
    }
    __syncthreads();
  }
}

struct ConvTile { const float* src; u16* dst; int K, N, k0, n0; };

__device__ __forceinline__ ConvTile conv_tile_params(const Params& p, int l, int set, int t) {
  char* wta = WS(p) + OFF_WTA;
  int tt = t;
  const float* src; int K, N; u16* dst;
  if (set == 0) {
    if (tt < 1120) { src = p.w_in + (size_t)l * 1024 * 4480; K = 1024; N = 4480; dst = (u16*)(wta + WO_IN); }
    else if ((tt -= 1120) < 128) { src = p.w_fourier_up + (size_t)l * 512 * 1024; K = 512; N = 1024; dst = (u16*)(wta + WO_FU); }
    else if ((tt -= 128) < 128) { src = p.w_rwkv_up + (size_t)l * 512 * 1024; K = 512; N = 1024; dst = (u16*)(wta + WO_RU); }
    else if ((tt -= 128) < 256) { src = p.w_out + (size_t)l * 1024 * 1024; K = 1024; N = 1024; dst = (u16*)(wta + WO_OUT); }
    else if ((tt -= 256) < 16) { const int d = tt >> 3; tt &= 7; src = p.w_up + (size_t)(l * 2 + d) * 64 * 512; K = 64; N = 512; dst = (u16*)(wta + WO_WUP) + d * 512 * 64; }
    else if ((tt -= 16) < 16) { const int d = tt >> 3; tt &= 7; src = p.a_up + (size_t)(l * 2 + d) * 64 * 512; K = 64; N = 512; dst = (u16*)(wta + WO_AUP) + d * 512 * 64; }
    else { tt -= 16; src = p.g_up + (size_t)l * 128 * 512; K = 128; N = 512; dst = (u16*)(wta + WO_GUP); }
  } else {
    if (tt < 1024) { src = p.mlp_w1 + (size_t)l * 1024 * 4096; K = 1024; N = 4096; dst = (u16*)(WS(p) + OFF_W1T); }
    else { tt -= 1024; src = p.mlp_w2 + (size_t)l * 4096 * 1024; K = 4096; N = 1024; dst = (u16*)(WS(p) + OFF_W2T); }
  }
  const int nT = N >> 6;
  ConvTile c; c.src = src; c.dst = dst; c.K = K; c.N = N; c.k0 = (tt / nT) * 64; c.n0 = (tt % nT) * 64;
  return c;
}

__device__ void conv_phase(const Params& p, int l, int set, char* lds, int first = -1, int stride = 0) {
  float* tileA = (float*)lds;
  float* tileB = tileA + 64 * 65;
  const int tid = TID();
  const int total = (set == 0) ? 1680 : 2048;
  const int t0 = (first < 0) ? BID() : first, tstep = (first < 0) ? (int)gridDim.x : stride;
  if (t0 >= total) return;
  const int lk = tid >> 6, ln = tid & 63;
  const int sn = tid >> 3, skc = (tid & 7) * 8;
  float a0, a1, a2, a3, a4, a5, a6, a7, b0, b1, b2, b3, b4, b5, b6, b7;
#define CONV_LOAD(c, R) do { const float* q_ = (c).src + (size_t)((c).k0 + lk) * (c).N + (c).n0 + ln; const size_t st_ = (size_t)8 * (c).N; \
    R##0 = q_[0]; R##1 = q_[st_]; R##2 = q_[2 * st_]; R##3 = q_[3 * st_]; R##4 = q_[4 * st_]; R##5 = q_[5 * st_]; R##6 = q_[6 * st_]; R##7 = q_[7 * st_]; } while (0)
#define CONV_PUT(T, R) do { T[(lk + 0) * 65 + ln] = R##0; T[(lk + 8) * 65 + ln] = R##1; T[(lk + 16) * 65 + ln] = R##2; T[(lk + 24) * 65 + ln] = R##3; \
    T[(lk + 32) * 65 + ln] = R##4; T[(lk + 40) * 65 + ln] = R##5; T[(lk + 48) * 65 + ln] = R##6; T[(lk + 56) * 65 + ln] = R##7; } while (0)
#define CONV_OUT(T, c) do { u16x8 o_; _Pragma("unroll") for (int j = 0; j < 8; ++j) o_[j] = f2bf(T[(skc + j) * 65 + sn]); \
    *(u16x8*)((c).dst + (size_t)((c).n0 + sn) * (c).K + (c).k0 + skc) = o_; } while (0)
  ConvTile ca = conv_tile_params(p, l, set, t0), cb = ca;
  bool hasb = (t0 + tstep) < total;
  CONV_LOAD(ca, a);
  if (hasb) { cb = conv_tile_params(p, l, set, t0 + tstep); CONV_LOAD(cb, b); }
  for (int t = t0; t < total; t += 2 * tstep) {
    __syncthreads();
    CONV_PUT(tileA, a);
    if (hasb) CONV_PUT(tileB, b);
    __syncthreads();
    const ConvTile da = ca, db = cb;
    const bool hadb = hasb;
    if (t + 2 * tstep < total) { ca = conv_tile_params(p, l, set, t + 2 * tstep); CONV_LOAD(ca, a); }
    hasb = (t + 3 * tstep) < total;
    if (hasb) { cb = conv_tile_params(p, l, set, t + 3 * tstep); CONV_LOAD(cb, b); }
    CONV_OUT(tileA, da);
    if (hadb) CONV_OUT(tileB, db);
  }
#undef CONV_LOAD
#undef CONV_PUT
#undef CONV_OUT
  __syncthreads();
}

__device__ void dftm_gen(const Params& p, char* lds) {
  u16* DM = (u16*)(WS(p) + OFF_AR);
  u16* tc = (u16*)lds;
  u16* ts = tc + 2048;
  const int tid = TID();
  const float TWO_PI = 6.283185307179586f;
  __syncthreads();
  for (int m = tid; m < 2048; m += NTHREADS) {
    float sn, cs;
    sincosf(TWO_PI * (float)m * (1.f / 2048.f), &sn, &cs);
    tc[m] = f2bf(cs);
    ts[m] = f2bf(-sn);
  }
  __syncthreads();
  const int gt = BID() * NTHREADS + tid, gs = gridDim.x * NTHREADS;
  for (int i = gt; i < 2048 * 256; i += gs) {
    const int k = i >> 8, c0 = (i & 255) * 8;
    const u16* tab = (c0 < 1024) ? tc : ts;
    const int l0 = c0 & 1023;
    u16x8 o;
#pragma unroll
    for (int j = 0; j < 8; ++j) o[j] = tab[(k * (l0 + j)) & 2047];
    *(u16x8*)(DM + (size_t)k * 2048 + c0) = o;
  }
  for (int i = gt; i < 256 * 32; i += gs) {
    const int k = i >> 5, l0 = (i & 31) * 8;
    u16x8 oc, os;
#pragma unroll
    for (int j = 0; j < 8; ++j) { const int m = ((k * (l0 + j)) & 255) * 8; oc[j] = tc[m]; os[j] = ts[m]; }
    *(u16x8*)(DM + DM_CC + (size_t)k * 256 + l0) = oc;
    *(u16x8*)(DM + DM_NSC + (size_t)k * 256 + l0) = os;
  }
  for (int i = gt; i < 256 * 16; i += gs) {
    const int row = i >> 4, c0 = (i & 15) * 8, jj = row & 127;
    u16x8 o;
#pragma unroll
    for (int j = 0; j < 8; ++j) { const int m = ((jj * (c0 + j)) & 127) * 16; o[j] = (row < 128) ? tc[m] : (u16)(ts[m] ^ 0x8000u); }
    *(u16x8*)(DM + DM_TW + (size_t)row * 128 + c0) = o;
  }
}

__device__ void normmod_phase(const Params& p, int l, int which, int ntok, u16* __restrict__ H, bool from_inputs, const u16* D = nullptr, const u16* PARTp = nullptr, const float* pgate = nullptr) {
  const float* MOD = (const float*)(WS(p) + OFF_MOD);
  const float* XC = from_inputs ? p.ctx : (const float*)(WS(p) + OFF_XC);
  const float* XL = from_inputs ? p.x : p.out;
  float* WC = (float*)(WS(p) + OFF_XC);
  float* WL = p.out;
  const float* nw = (which == 0 ? p.norm1 : p.norm2) + l * 1024;
  const int lane = TID() & 63;
  const int gw = BID() * 8 + (TID() >> 6), nw_ = gridDim.x * 8;
  float4 vn[4];
  if (gw < ntok) {
    const float* x0 = (gw < TL) ? (XL + (size_t)gw * 1024) : (XC + (size_t)(gw - TL) * 1024);
#pragma unroll
    for (int j = 0; j < 4; ++j) vn[j] = *(const float4*)(x0 + j * 256 + lane * 4);
  }
  for (int t = gw; t < ntok; t += nw_) {
    const size_t roff = (t < TL) ? ((size_t)t * 1024) : ((size_t)(t - TL) * 1024);
    const int mrow = (t < TL) ? (t >> 11) : 8;
    const float* mo = MOD + ((size_t)l * 9 + mrow) * 6144 + which * 3072;
    float4 v[4];
    ushort4 dq[4];
#pragma unroll
    for (int j = 0; j < 4; ++j) v[j] = vn[j];
    {
      const int t2 = t + nw_;
      if (t2 < ntok) {
        const float* x2 = (t2 < TL) ? (XL + (size_t)t2 * 1024) : (XC + (size_t)(t2 - TL) * 1024);
#pragma unroll
        for (int j = 0; j < 4; ++j) vn[j] = *(const float4*)(x2 + j * 256 + lane * 4);
      }
    }
    const bool ctxpart = PARTp && t >= TL;
    if (ctxpart) {
#pragma unroll
      for (int j = 0; j < 4; ++j) {
        const int c0 = j * 256 + lane * 4;
        float sx = 0.f, sy = 0.f, sz = 0.f, sw = 0.f;
#pragma unroll
        for (int ks = 0; ks < 4; ++ks) {
          const ushort4 q = *(const ushort4*)(PARTp + ((size_t)ks * 2048 + (t - TL)) * 1024 + c0);
          sx += bf2f(q.x); sy += bf2f(q.y); sz += bf2f(q.z); sw += bf2f(q.w);
        }
        float4 gg = float4{1.f, 1.f, 1.f, 1.f};
        if (pgate) gg = *(const float4*)(pgate + c0);
        v[j].x += gg.x * sx; v[j].y += gg.y * sy; v[j].z += gg.z * sz; v[j].w += gg.w * sw;
      }
      if (D) {
        float* xw = WC + roff;
#pragma unroll
        for (int j = 0; j < 4; ++j) *(float4*)(xw + j * 256 + lane * 4) = v[j];
      }
    }
    if (D && !ctxpart) {
#pragma unroll
      for (int j = 0; j < 4; ++j) dq[j] = *(const ushort4*)(D + (size_t)t * 1024 + j * 256 + lane * 4);
      float* xw = ((t < TL) ? WL : WC) + roff;
#pragma unroll
      for (int j = 0; j < 4; ++j) {
        v[j].x += bf2f(dq[j].x); v[j].y += bf2f(dq[j].y); v[j].z += bf2f(dq[j].z); v[j].w += bf2f(dq[j].w);
        *(float4*)(xw + j * 256 + lane * 4) = v[j];
      }
    }
    float ss = 0.f;
#pragma unroll
    for (int j = 0; j < 4; ++j) ss += v[j].x * v[j].x + v[j].y * v[j].y + v[j].z * v[j].z + v[j].w * v[j].w;
    ss = wave_sum(ss);
    const float inv = rsqrtf(ss * (1.f / 1024.f) + 1e-6f);
#pragma unroll
    for (int j = 0; j < 4; ++j) {
      const int c0 = j * 256 + lane * 4;
      float4 g = *(const float4*)(nw + c0);
      float4 sh = *(const float4*)(mo + c0);
      float4 sc = *(const float4*)(mo + 1024 + c0);
      ushort4 o;
      o.x = f2bf(v[j].x * inv * g.x * (1.f + sc.x) + sh.x);
      o.y = f2bf(v[j].y * inv * g.y * (1.f + sc.y) + sh.y);
      o.z = f2bf(v[j].z * inv * g.z * (1.f + sc.z) + sh.z);
      o.w = f2bf(v[j].w * inv * g.w * (1.f + sc.w) + sh.w);
      *(ushort4*)(H + (size_t)t * 1024 + c0) = o;
    }
  }
}

__device__ void final_norm(const Params& p) {
  const u16* D2 = (const u16*)(WS(p) + OFF_EH);
  const int lane = TID() & 63;
  const int gw = BID() * 8 + (TID() >> 6), nw_ = gridDim.x * 8;
  for (int t = gw; t < TL; t += nw_) {
    float* xr = p.out + (size_t)t * 1024;
    float4 v[4];
    float ss = 0.f;
#pragma unroll
    for (int j = 0; j < 4; ++j) {
      v[j] = *(const float4*)(xr + j * 256 + lane * 4);
      const ushort4 dq = *(const ushort4*)(D2 + (size_t)t * 1024 + j * 256 + lane * 4);
      v[j].x += bf2f(dq.x); v[j].y += bf2f(dq.y); v[j].z += bf2f(dq.z); v[j].w += bf2f(dq.w);
      ss += v[j].x * v[j].x + v[j].y * v[j].y + v[j].z * v[j].z + v[j].w * v[j].w;
    }
    ss = wave_sum(ss);
    const float inv = rsqrtf(ss * (1.f / 1024.f) + 1e-6f);
#pragma unroll
    for (int j = 0; j < 4; ++j) {
      const int c0 = j * 256 + lane * 4;
      float4 g = *(const float4*)(p.norm_f + c0);
      float4 o;
      o.x = v[j].x * inv * g.x; o.y = v[j].y * inv * g.y; o.z = v[j].z * inv * g.z; o.w = v[j].w * inv * g.w;
      *(float4*)(xr + c0) = o;
    }
  }
}

__device__ void prep3a_phase(const Params& p, int l) {
  const f16* RW = (const f16*)(WS(p) + OFF_RW);
  f16* Rb = (f16*)(WS(p) + OFF_R);
  f16* Kb = (f16*)(WS(p) + OFF_K);
  f16* Vb = (f16*)(WS(p) + OFF_V);
  u16* LORA = (u16*)(WS(p) + OFF_LORA);
  u16* GDS = (u16*)(WS(p) + OFF_GDS);
  float* INVN = (float*)(WS(p) + OFF_INVN);
  const float* mu = p.mu_shift + (size_t)l * 1920;
  const float* kk_w = p.k_k + (size_t)l * 512;
  const int lane = TID() & 63;
  const int gw = BID() * 8 + (TID() >> 6), nw_ = gridDim.x * 8;
  float mm[4][8], kw[8];
  bool valid[4];
#pragma unroll
  for (int it = 0; it < 4; ++it) {
    const int chunk = it * 64 + lane;
    valid[it] = chunk < 240;
    const int c0 = valid[it] ? chunk * 8 : 0;
    const float4 m0 = *(const float4*)(mu + c0), m1 = *(const float4*)(mu + c0 + 4);
    mm[it][0] = m0.x; mm[it][1] = m0.y; mm[it][2] = m0.z; mm[it][3] = m0.w;
    mm[it][4] = m1.x; mm[it][5] = m1.y; mm[it][6] = m1.z; mm[it][7] = m1.w;
  }
  {
    const float4 k0 = *(const float4*)(kk_w + lane * 8), k1 = *(const float4*)(kk_w + lane * 8 + 4);
    kw[0] = k0.x; kw[1] = k0.y; kw[2] = k0.z; kw[3] = k0.w; kw[4] = k1.x; kw[5] = k1.y; kw[6] = k1.z; kw[7] = k1.w;
  }
  for (int t = gw; t < TA; t += nw_) {
    const bool lat = t < TL;
    int pos, row = 0, colg = 0;
    if (lat) { pos = t & 2047; row = pos >> 6; colg = pos & 63; } else { pos = (t - TL) & 255; }
    f16x8 raw[4], nbv[4];
#pragma unroll
    for (int it = 0; it < 4; ++it) {
      const int chunk = it * 64 + lane;
      const int c0 = chunk * 8;
      int nb = -1;
      if (lat) {
        const int q = c0 / 480;
        if (q == 0) { if (colg > 0) nb = t - 1; }
        else if (q == 1) { if (colg < 63) nb = t + 1; }
        else if (q == 2) { if (row > 0) nb = t - 64; }
        else { if (row < 31) nb = t + 64; }
      } else {
        if (c0 < 960) { if (pos > 0) nb = t - 1; }
        else { if (pos < 255) nb = t + 1; }
      }
#pragma unroll
      for (int j = 0; j < 8; ++j) { raw[it][j] = (f16)0.f; nbv[it][j] = (f16)0.f; }
      if (valid[it]) {
        raw[it] = *(const f16x8*)(RW + (size_t)t * 1920 + c0);
        if (nb >= 0) nbv[it] = *(const f16x8*)(RW + (size_t)nb * 1920 + c0);
      }
    }
#pragma unroll
    for (int it = 0; it < 4; ++it) {
      const int chunk = it * 64 + lane;
      if (valid[it]) {
        const int c0 = chunk * 8;
        float s[8];
#pragma unroll
        for (int j = 0; j < 8; ++j) {
          float a = (float)raw[it][j], b = (float)nbv[it][j];
          s[j] = a + mm[it][j] * (b - a);
        }
        if (it < 3) {
          f16x8 o;
#pragma unroll
          for (int j = 0; j < 8; ++j) o[j] = f2h(s[j]);
          f16* dst = (it == 0) ? Rb : ((it == 1) ? Kb : Vb);
          *(f16x8*)(dst + (size_t)t * 512 + (c0 - it * 512)) = o;
          if (it == 1) {
            float ss = 0.f;
#pragma unroll
            for (int j = 0; j < 8; ++j) { float q = (float)o[j] * kw[j]; ss += q * q; }
            ss = red8(ss);
            if ((lane & 7) == 0) INVN[(size_t)t * 8 + (lane >> 3)] = 1.f / fmaxf(sqrtf(ss), 1e-12f);
          }
        } else if (c0 < 1792) {
          u16x8 o;
          const bool th = c0 < 1664;
#pragma unroll
          for (int j = 0; j < 8; ++j) o[j] = f2bf(th ? tanhf(s[j]) : s[j]);
          *(u16x8*)(LORA + (size_t)t * 256 + (c0 - 1536)) = o;
        } else {
          u16x8 o;
#pragma unroll
          for (int j = 0; j < 8; ++j) o[j] = f2bf(sigmoidf_(s[j]));
          *(u16x8*)(GDS + (size_t)t * 128 + (c0 - 1792)) = o;
        }
      }
    }
  }
}

__device__ void post5a_phase(const Params& p, int l, int ntok) {
  const f16* Rb = (const f16*)(WS(p) + OFF_R);
  const f16* Kb = (const f16*)(WS(p) + OFF_K);
  const f16* Vb = (const f16*)(WS(p) + OFF_V);
  const f16* A0 = (const f16*)(WS(p) + OFF_AR);
  const f16* A1 = A0 + (size_t)TA * 512;
  f16* Y0 = (f16*)(WS(p) + OFF_YS0);
  const f16* Y1 = (const f16*)(WS(p) + OFF_YS1);
  const int lane = TID() & 63;
  const int c0 = lane * 8;
  float ka[8], rk[8], lw[8], lb[8];
#pragma unroll
  for (int j = 0; j < 8; ++j) {
    ka[j] = p.k_a[l * 512 + c0 + j];
    rk[j] = p.r_k[l * 512 + c0 + j];
    lw[j] = p.ln_x_w[l * 512 + c0 + j];
    lb[j] = p.ln_x_b[l * 512 + c0 + j];
  }
  const int gw = BID() * 8 + (TID() >> 6), nw_ = gridDim.x * 8;
  for (int t = gw; t < ntok; t += nw_) {
    const size_t o = (size_t)t * 512 + c0;
    f16x8 r = *(const f16x8*)(Rb + o), k = *(const f16x8*)(Kb + o), v = *(const f16x8*)(Vb + o);
    f16x8 a0 = *(const f16x8*)(A0 + o), a1 = *(const f16x8*)(A1 + o);
    f16x8 y0 = *(const f16x8*)(Y0 + o), y1 = *(const f16x8*)(Y1 + o);
    float y[8], bs = 0.f, sum = 0.f;
#pragma unroll
    for (int j = 0; j < 8; ++j) {
      float kf = (float)k[j];
      float kd0 = kf * (1.f + ((float)a0[j] - 1.f) * ka[j]);
      float kd1 = kf * (1.f + ((float)a1[j] - 1.f) * ka[j]);
      bs += (float)r[j] * (kd0 + kd1) * rk[j];
      y[j] = (float)y0[j] + (float)y1[j];
      sum += y[j];
    }
    bs = red8(bs);
    sum = red8(sum);
    const float mean = sum * (1.f / 64.f);
    float vs = 0.f;
#pragma unroll
    for (int j = 0; j < 8; ++j) { float d = y[j] - mean; vs += d * d; }
    vs = red8(vs);
    const float rstd = rsqrtf(vs * (1.f / 64.f) + 64e-5f);
    u16x8 z;
#pragma unroll
    for (int j = 0; j < 8; ++j) {
      float yn = (y[j] - mean) * rstd * lw[j] + lb[j];
      z[j] = f2bf(yn + bs * (float)v[j]);
    }
    *(u16x8*)((u16*)Y0 + o) = z;
  }
}

constexpr int TB = 32;
constexpr int NBLK = 2304 / TB;
constexpr int ST_VEC = TB * 320;
constexpr int ST_FLOATS = ST_VEC + TB * 32 * 2;

__device__ __forceinline__ int scan_token(int d, int b, int s) {
  if (s < 256) return TL + b * 256 + (d == 0 ? s : 255 - s);
  const int s2 = s - 256;
  return b * 2048 + (d == 0 ? s2 : 2047 - s2);
}

__device__ __forceinline__ float red16(float x) {
  x += dpp_f<0xB1>(x);
  x += dpp_f<0x4E>(x);
  x += dpp_f<0x141>(x);
  x += dpp_f<0x140>(x);
  return x;
}

constexpr int SC_VEC = TB * 256;
constexpr int SC_P = SC_VEC;
constexpr int SC_V = SC_VEC + 64;
constexpr int SC_Y = SC_V + TB * 32;
constexpr int SC_FLOATS = SC_Y + TB * 32;

#define SCAN_BAR() do { asm volatile("s_waitcnt lgkmcnt(0)" ::: "memory"); __builtin_amdgcn_s_barrier(); asm volatile("" ::: "memory"); } while (0)
__device__ void scan_phase(const Params& p, int l, char* lds) {
  float* st = (float*)lds;
  const f16* Rb = (const f16*)(WS(p) + OFF_R);
  const f16* Kb = (const f16*)(WS(p) + OFF_K);
  const f16* Vb = (const f16*)(WS(p) + OFF_V);
  const float* INVN = (const float*)(WS(p) + OFF_INVN);
  const int tid = TID();
  for (int item = BID(); item < 256; item += gridDim.x) {
    const int chain = item >> 1, half = item & 1;
    const int d = chain >> 6, b = (chain >> 3) & 7, h = chain & 7;
    const f16* Eb = (const f16*)(WS(p) + OFF_EH) + (size_t)d * TA * 512;
    const f16* Ab = (const f16*)(WS(p) + OFF_AR) + (size_t)d * TA * 512;
    f16* Yb = (f16*)(WS(p) + (d == 0 ? OFF_YS0 : OFF_YS1));
    __syncthreads();
    if (__builtin_amdgcn_readfirstlane(tid >> 6) >= 4) {
      const int lt = tid - 256;
      const int k = lt & 63, sgp = __builtin_amdgcn_readfirstlane(lt >> 6);
      const int ch = h * 64 + k;
      const float kkw = p.k_k[l * 512 + ch], kaw = p.k_a[l * 512 + ch];
      const int vstep = lt >> 3, vcol = h * 64 + half * 32 + (lt & 7) * 4;
      f16 ev[TB], kv[8], rv[8], av[8];
      float invn[8];
      f16x4 vv;
      const int dir = d ? -1 : 1;
      auto issue = [&](int blk) {
        const int tok0 = __builtin_amdgcn_readfirstlane(scan_token(d, b, blk * TB));
        const f16* pe = Eb + (size_t)tok0 * 512;
#pragma unroll
        for (int t = 0; t < TB; ++t) ev[t] = pe[(ptrdiff_t)(dir * t) * 512 + ch];
        const int tokg = __builtin_amdgcn_readfirstlane(tok0 + dir * sgp * 8);
#pragma unroll
        for (int j = 0; j < 8; ++j) {
          const ptrdiff_t o = (ptrdiff_t)(tokg + dir * j) * 512;
          kv[j] = (Kb + o)[ch]; rv[j] = (Rb + o)[ch]; av[j] = (Ab + o)[ch];
          invn[j] = INVN[(size_t)(tokg + dir * j) * 8 + h];
        }
        vv = *(const f16x4*)(Vb + (size_t)(tok0 + dir * vstep) * 512 + vcol);
      };
      auto commit = [&](int blk) {
        float* sg = st + (blk & 1) * SC_FLOATS;
        float cum = 0.f;
#pragma unroll
        for (int t = 0; t < TB; ++t) {
          cum += (t < sgp * 8) ? (float)ev[t] : 0.f;
        }
#pragma unroll
        for (int j = 0; j < 8; ++j) {
          float e = 0.f;
#pragma unroll
          for (int g = 0; g < 4; ++g) e = (sgp == g) ? (float)ev[g * 8 + j] : e;
          const float pprev = __expf(-cum);
          cum += e;
          const float pt = __expf(-cum), ipt = __expf(cum);
          const float kf = (float)kv[j], af = (float)av[j];
          const float q = kf * kkw * invn[j];
          float* base = sg + (sgp * 8 + j) * 256 + k;
          base[0] = q * pprev;
          base[64] = q * af * ipt;
          base[128] = kf * (1.f + (af - 1.f) * kaw) * ipt;
          base[192] = (float)rv[j] * pt;
        }
        if (sgp == 3) sg[SC_P + k] = __expf(-cum);
        *(float4*)(sg + SC_V + vstep * 32 + (lt & 7) * 4) = float4{(float)vv[0], (float)vv[1], (float)vv[2], (float)vv[3]};
      };
      auto store_y = [&](int blk) {
        const float* sg = st + (blk & 1) * SC_FLOATS;
        const int tok = __builtin_amdgcn_readfirstlane(scan_token(d, b, blk * TB)) + dir * vstep;
        const float4 yv = *(const float4*)(sg + SC_Y + vstep * 32 + (lt & 7) * 4);
        f16x4 o;
        o[0] = f2h(yv.x); o[1] = f2h(yv.y); o[2] = f2h(yv.z); o[3] = f2h(yv.w);
        *(f16x4*)(Yb + (size_t)tok * 512 + vcol) = o;
      };
      issue(0);
      commit(0);
      issue(1);
      __syncthreads();
      for (int blk = 0; blk < NBLK; ++blk) {
        if (blk + 1 < NBLK) commit(blk + 1);
        if (blk + 2 < NBLK) issue(blk + 2);
        if (blk > 0) store_y(blk - 1);
        SCAN_BAR();
      }
      store_y(NBLK - 1);
    } else {
      const int lane = tid & 63, wave = tid >> 6;
      const int rl = wave * 8 + (lane >> 3), kp = lane & 7;
      f32x2 SA = f32x2{0.f, 0.f}, SB = SA, SC = SA, SD = SA;
      __syncthreads();
      for (int blk = 0; blk < NBLK; ++blk) {
        float* sg = st + (blk & 1) * SC_FLOATS;
        const float* vb = sg + SC_V + rl;
        float* yb = sg + SC_Y + rl;
        float ys0 = 0.f, ys1 = 0.f, ys2 = 0.f, ys3 = 0.f;
        const float* base0 = sg + kp * 8;
        f32x4 q0 = *(const f32x4*)(base0 + 0), q1 = *(const f32x4*)(base0 + 4);
        f32x4 a0 = *(const f32x4*)(base0 + 64), a1 = *(const f32x4*)(base0 + 68);
        f32x4 d0 = *(const f32x4*)(base0 + 128), d1 = *(const f32x4*)(base0 + 132);
        f32x4 r0 = *(const f32x4*)(base0 + 192), r1 = *(const f32x4*)(base0 + 196);
        float vv = vb[0];
#pragma unroll
        for (int u = 0; u < TB; ++u) {
          f32x4 nq0, nq1, na0, na1, nd0, nd1, nr0, nr1;
          float nvv;
          if (u + 1 < TB) {
            const float* nb = base0 + (u + 1) * 256;
            nq0 = *(const f32x4*)(nb + 0); nq1 = *(const f32x4*)(nb + 4);
            na0 = *(const f32x4*)(nb + 64); na1 = *(const f32x4*)(nb + 68);
            nd0 = *(const f32x4*)(nb + 128); nd1 = *(const f32x4*)(nb + 132);
            nr0 = *(const f32x4*)(nb + 192); nr1 = *(const f32x4*)(nb + 196);
            nvv = vb[(u + 1) * 32];
          }
          __builtin_amdgcn_sched_barrier(0x7);
          f32x2 pp = SA * q0.xy;
          pp = __builtin_elementwise_fma(SB, q0.zw, pp);
          pp = __builtin_elementwise_fma(SC, q1.xy, pp);
          pp = __builtin_elementwise_fma(SD, q1.zw, pp);
          const float sa = red8(pp.x + pp.y);
          const f32x2 v2 = f32x2{vv, vv}, ns = f32x2{-sa, -sa};
          SA = __builtin_elementwise_fma(v2, d0.xy, SA);
          SB = __builtin_elementwise_fma(v2, d0.zw, SB);
          SC = __builtin_elementwise_fma(v2, d1.xy, SC);
          SD = __builtin_elementwise_fma(v2, d1.zw, SD);
          SA = __builtin_elementwise_fma(ns, a0.xy, SA);
          SB = __builtin_elementwise_fma(ns, a0.zw, SB);
          SC = __builtin_elementwise_fma(ns, a1.xy, SC);
          SD = __builtin_elementwise_fma(ns, a1.zw, SD);
          f32x2 yy = SA * r0.xy;
          yy = __builtin_elementwise_fma(SB, r0.zw, yy);
          yy = __builtin_elementwise_fma(SC, r1.xy, yy);
          yy = __builtin_elementwise_fma(SD, r1.zw, yy);
          const float y = red8(yy.x + yy.y);
          if (u < 8) ys0 = ((u & 7) == kp) ? y : ys0;
          else if (u < 16) ys1 = ((u & 7) == kp) ? y : ys1;
          else if (u < 24) ys2 = ((u & 7) == kp) ? y : ys2;
          else ys3 = ((u & 7) == kp) ? y : ys3;
          if (u + 1 < TB) { q0 = nq0; q1 = nq1; a0 = na0; a1 = na1; d0 = nd0; d1 = nd1; r0 = nr0; r1 = nr1; vv = nvv; }
        }
        {
          const f32x4 p0 = *(const f32x4*)(sg + SC_P + kp * 8), p1 = *(const f32x4*)(sg + SC_P + kp * 8 + 4);
          SA *= p0.xy; SB *= p0.zw; SC *= p1.xy; SD *= p1.zw;
        }
        yb[kp * 32] = ys0;
        yb[(8 + kp) * 32] = ys1;
        yb[(16 + kp) * 32] = ys2;
        yb[(24 + kp) * 32] = ys3;
        SCAN_BAR();
      }
    }
  }
}

namespace pg8 {
#define PG8_LAS __attribute__((address_space(3)))
typedef unsigned short bf16_t;
typedef short bf16x8 __attribute__((ext_vector_type(8)));
typedef float f32x4 __attribute__((ext_vector_type(4)));
typedef unsigned u32x4 __attribute__((ext_vector_type(4)));
constexpr int BM = 256, BK = 64, HALF = 128, HTB = HALF * BK * 2  , STAGE_BYTES = 8 * HTB, NXCD = 8, WGM = 8;

__host__ __device__ __forceinline__ int lds_byte(int r, int c) { const int st = (r >> 4) * 2 + (c >> 5), rr = r & 15, cc = c & 31, ob = rr * 64 + cc * 2; return st * 1024 + (ob ^ (((ob >> 9) & 1) << 5)); }
__host__ __device__ __forceinline__ void stage_rc(int b, int& R, int& C) { const int st = b / 1024, sb = b % 1024, swz = sb ^ (((sb >> 9) & 1) << 5); R = (st >> 1) * 16 + swz / 64; C = (st & 1) * 32 + (swz % 64) / 2; }
__host__ __device__ __forceinline__ int perm32(int rho) { const int n = rho >> 4, i = rho & 15; return 8 * (i >> 2) + 4 * n + (i & 3); }

struct Unit { int pm, pn; };
struct Gemm { const bf16_t* A; const bf16_t* Bt; int M, N, K; };

struct StaticOrder {
    int nM, nN, nwg, G, c;
    __host__ __device__ void init(int M, int N, int G_, int c_) { nM = M / BM; nN = N / BM; nwg = nM * nN; G = G_; c = c_; }
    __host__ __device__ bool next(int i, Unit& u) const {
        const long L = (long)i * G + c; if (L >= nwg) return false;
        int wgid = (int)L; { const int q = nwg / NXCD, r = nwg % NXCD, xcd = wgid % NXCD, off = wgid / NXCD; wgid = (xcd < r ? xcd * (q + 1) : r * (q + 1) + (xcd - r) * q) + off; }
        const int nig = WGM * nN, gid = wgid / nig, fm = gid * WGM, gsz = (nM - fm) < WGM ? (nM - fm) : WGM;
        u.pm = fm + ((wgid % nig) % gsz); u.pn = (wgid % nig) / gsz; return true;
    }
    __device__ __forceinline__ void a_ready(const Unit&) const {}
    __device__ __forceinline__ void done(const Unit&) const {}
};
__device__ __forceinline__ unsigned cvt_pk_bf16(float lo, float hi) { unsigned r; asm volatile("v_cvt_pk_bf16_f32 %0, %1, %2" : "=v"(r) : "v"(lo), "v"(hi)); return r; }
typedef float f32x2 __attribute__((ext_vector_type(2)));
template <class Epi, class Sched, bool STAMP = false>
__device__ __forceinline__ void gemm_phase(PG8_LAS unsigned char* lds, const Gemm g, const Sched& S, const Epi& E, unsigned long long* stamps) {
    const int tid = TID(), wid = __builtin_amdgcn_readfirstlane(tid >> 6), lane = tid & 63, wr = wid >> 2, wc = wid & 3, fr = lane & 15, fq = lane >> 4;
    const int K = g.K, nt = K / BK;
    int ts_lo = 0, ts_hi = 0, nts = 0; const unsigned long long rt_entry = STAMP ? (unsigned long long)wall_clock64() : 0ull;
#define PG8_STAMP() do { if (STAMP && wid == 0 && nts < 64) { const unsigned long long _c = (unsigned long long)clock64(); \
        ts_lo = (lane == nts) ? (int)(unsigned)_c : ts_lo; ts_hi = (lane == nts) ? (int)(unsigned)(_c >> 32) : ts_hi; ++nts; } } while (0)
    PG8_STAMP();
    unsigned voffA[2], voffB[2];
#pragma unroll
    for (int i = 0; i < 2; ++i) { int R, C; stage_rc(tid * 16 + i * 8192, R, C); const int Rb = Epi::PERM ? ((R & ~31) + perm32(R & 31)) : R;
        voffA[i] = (unsigned)(R * K + C) * 2u; voffB[i] = (unsigned)(Rb * K + C) * 2u; }
    const size_t kstep = (size_t)(BK * 2);
    const size_t hstep = (size_t)HALF * K * 2;
    const size_t tstep = 2 * hstep;
    const unsigned ldsw = (unsigned)wid * 1024u;
    const int aoff = lds_byte(wr * 64 + fr, fq * 8), boff = lds_byte(wc * 32 + fr, fq * 8);
#define PG8_SA(b, h) (((b) * 2 + (h)) * HTB)
#define PG8_SB(b, h) ((4 + (b) * 2 + (h)) * HTB)
#define PG8_STAGE(bufoff, gbase, voff) do { _Pragma("unroll") for (int _i = 0; _i < 2; ++_i) \
        __builtin_amdgcn_global_load_lds((const unsigned*)((const char*)(gbase) + (voff)[_i]), (PG8_LAS unsigned*)(lds + (bufoff) + ldsw + _i * 8192), 16, 0, 0); } while (0)
#define PG8_LDA(dst, b, h) do { _Pragma("unroll") for (int m = 0; m < 4; ++m) _Pragma("unroll") for (int k = 0; k < 2; ++k) dst[m][k] = *(const PG8_LAS bf16x8*)(lds + PG8_SA(b, h) + aoff + m * 2048 + k * 1024); } while (0)
#define PG8_LDB(dst, b, h) do { _Pragma("unroll") for (int n = 0; n < 2; ++n) _Pragma("unroll") for (int k = 0; k < 2; ++k) dst[n][k] = *(const PG8_LAS bf16x8*)(lds + PG8_SB(b, h) + boff + n * 2048 + k * 1024); } while (0)
#define PG8_MMA(ai, bj, At, Bt) do { __builtin_amdgcn_s_setprio(1); _Pragma("unroll") for (int m = 0; m < 4; ++m) _Pragma("unroll") for (int n = 0; n < 2; ++n) _Pragma("unroll") for (int k = 0; k < 2; ++k) \
        acc[ai][bj][m][n] = __builtin_amdgcn_mfma_f32_16x16x32_bf16(Bt[n][k], At[m][k], acc[ai][bj][m][n], 0, 0, 0); __builtin_amdgcn_s_setprio(0); } while (0)
#define PG8_WAIT_V(n) asm volatile("s_waitcnt vmcnt(" #n ")" ::: "memory")
#define PG8_WAIT_L(n) asm volatile("s_waitcnt lgkmcnt(" #n ")" ::: "memory")
#define PG8_BAR __builtin_amdgcn_s_barrier()
#define PG8_SCHED __builtin_amdgcn_sched_barrier(0)
    Unit cur, nxt; int ui = 0;
    if (!S.next(0, cur)) return;
    f32x4 acc[2][2][4][2];
#pragma unroll
    for (int a = 0; a < 2; ++a)
#pragma unroll
        for (int b = 0; b < 2; ++b)
#pragma unroll
            for (int m = 0; m < 4; ++m)
#pragma unroll
                for (int n = 0; n < 2; ++n) acc[a][b][m][n] = (f32x4){0.f, 0.f, 0.f, 0.f};
    bf16x8 At[4][2], B0[2][2], B1[2][2];
    const char* cA = (const char*)g.A + (size_t)cur.pm * tstep; const char* cB = (const char*)g.Bt + (size_t)cur.pn * tstep;
    S.a_ready(cur);
    PG8_STAGE(PG8_SB(0, 0), cB, voffB); PG8_STAGE(PG8_SA(0, 0), cA, voffA); PG8_STAGE(PG8_SB(0, 1), cB + hstep, voffB); PG8_STAGE(PG8_SA(0, 1), cA + hstep, voffA);
    if (wr == 1) PG8_BAR;
    PG8_WAIT_V(4); PG8_BAR;
    PG8_STAGE(PG8_SB(1, 0), cB + kstep, voffB); PG8_STAGE(PG8_SA(1, 0), cA + kstep, voffA); PG8_STAGE(PG8_SB(1, 1), cB + hstep + kstep, voffB);
    PG8_WAIT_V(6); PG8_BAR;
    PG8_STAMP();
    for (;;) {
        const bool has_next = S.next(ui + 1, nxt);
        const char* nA = has_next ? (const char*)g.A + (size_t)nxt.pm * tstep : cA; const char* nB = has_next ? (const char*)g.Bt + (size_t)nxt.pn * tstep : cB;
        for (int t = 0; t < nt; t += 2) {
            const bool last = (t == nt - 2);
            const char* a1 = cA + (size_t)(t + 1) * kstep;
            const char* a2 = last ? nA : cA + (size_t)(t + 2) * kstep; const char* b2 = last ? nB : cB + (size_t)(t + 2) * kstep;
            const char* a3 = a2 + kstep; const char* b3 = b2 + kstep;
            if (last && has_next) S.a_ready(nxt);
            PG8_LDB(B0, 0, 0); PG8_SCHED; PG8_LDA(At, 0, 0); PG8_STAGE(PG8_SA(1, 1), a1 + hstep, voffA);
            PG8_WAIT_L(8); PG8_BAR; PG8_WAIT_L(0); PG8_MMA(0, 0, At, B0); PG8_BAR; PG8_SCHED;
            PG8_LDB(B1, 0, 1); PG8_STAGE(PG8_SB(0, 0), b2, voffB);
            PG8_BAR; PG8_WAIT_L(0); PG8_MMA(0, 1, At, B1); PG8_BAR;
            PG8_LDA(At, 0, 1); PG8_STAGE(PG8_SA(0, 0), a2, voffA);
            PG8_BAR; PG8_WAIT_L(0); PG8_MMA(1, 0, At, B0); PG8_BAR; PG8_SCHED;
            PG8_STAGE(PG8_SB(0, 1), b2 + hstep, voffB);
            PG8_WAIT_V(6); PG8_BAR; PG8_MMA(1, 1, At, B1); PG8_BAR;
            PG8_LDB(B0, 1, 0); PG8_SCHED; PG8_LDA(At, 1, 0); PG8_STAGE(PG8_SA(0, 1), a2 + hstep, voffA);
            PG8_WAIT_L(8); PG8_BAR; PG8_WAIT_L(0); PG8_MMA(0, 0, At, B0); PG8_BAR; PG8_SCHED;
            PG8_LDB(B1, 1, 1); PG8_STAGE(PG8_SB(1, 0), b3, voffB);
            PG8_BAR; PG8_WAIT_L(0); PG8_MMA(0, 1, At, B1); PG8_BAR;
            PG8_LDA(At, 1, 1); PG8_STAGE(PG8_SA(1, 0), a3, voffA);
            PG8_BAR; PG8_WAIT_L(0); PG8_MMA(1, 0, At, B0); PG8_BAR; PG8_SCHED;
            PG8_STAGE(PG8_SB(1, 1), b3 + hstep, voffB);
            PG8_WAIT_V(6); PG8_BAR; PG8_MMA(1, 1, At, B1); PG8_BAR;
        }
        PG8_STAMP();
        if constexpr (!Epi::AFTER_DRAIN) { E(acc, cur, wr, wc, fr, fq); S.done(cur); }
        PG8_STAMP();
        if (!has_next) break;
#pragma unroll
        for (int a = 0; a < 2; ++a)
#pragma unroll
            for (int b = 0; b < 2; ++b)
#pragma unroll
                for (int m = 0; m < 4; ++m)
#pragma unroll
                    for (int n = 0; n < 2; ++n) acc[a][b][m][n] = (f32x4){0.f, 0.f, 0.f, 0.f};
        cur = nxt; cA = nA; cB = nB; ++ui;
    }
    PG8_WAIT_V(0);
    if (wr == 0) PG8_BAR;
    PG8_BAR;
    if constexpr (Epi::AFTER_DRAIN) { E.fused(acc, cur, wr, wc, fr, fq, lds, wid, lane); S.done(cur); }
    PG8_STAMP();
    if (STAMP && wid == 0) { stamps[lane] = lane < nts ? (((unsigned long long)(unsigned)ts_hi << 32) | (unsigned)ts_lo) : 0ull;
        if (lane == 62) stamps[62] = rt_entry; if (lane == 63) stamps[63] = (unsigned long long)wall_clock64(); }
#undef PG8_STAMP
#undef PG8_SA
#undef PG8_SB
#undef PG8_STAGE
#undef PG8_LDA
#undef PG8_LDB
#undef PG8_MMA
#undef PG8_WAIT_V
#undef PG8_WAIT_L
#undef PG8_BAR
#undef PG8_SCHED
}
}

template <class F>
__device__ __forceinline__ void pg8_epi8(const pg8::f32x4 (&acc)[2][2][4][2], const pg8::Unit& u, int wr, int wc, int fr, int fq, F f) {
  const int row0 = u.pm * 256 + wr * 64 + fr, col0 = u.pn * 256 + wc * 32 + 8 * fq;
#pragma unroll
  for (int ai = 0; ai < 2; ++ai)
#pragma unroll
    for (int m = 0; m < 4; ++m)
#pragma unroll
      for (int bj = 0; bj < 2; ++bj) f(row0 + ai * 128 + m * 16, col0 + bj * 128, acc[ai][bj][m][0], acc[ai][bj][m][1]);
}
template <class F>
__device__ __forceinline__ void pg8_epi4(const pg8::f32x4 (&acc)[2][2][4][2], const pg8::Unit& u, int wr, int wc, int fr, int fq, F f) {
  const int row0 = u.pm * 256 + wr * 64 + fr, col0 = u.pn * 256 + wc * 32 + 4 * fq;
#pragma unroll
  for (int ai = 0; ai < 2; ++ai)
#pragma unroll
    for (int m = 0; m < 4; ++m)
#pragma unroll
      for (int bj = 0; bj < 2; ++bj)
#pragma unroll
        for (int n = 0; n < 2; ++n) f(row0 + ai * 128 + m * 16, col0 + bj * 128 + n * 16, acc[ai][bj][m][n]);
}
__device__ __forceinline__ pg8::u32x4 pk8_bf16(const pg8::f32x4 v0, const pg8::f32x4 v1) {
  pg8::u32x4 w;
  w.x = pg8::cvt_pk_bf16(v0[0], v0[1]); w.y = pg8::cvt_pk_bf16(v0[2], v0[3]);
  w.z = pg8::cvt_pk_bf16(v1[0], v1[1]); w.w = pg8::cvt_pk_bf16(v1[2], v1[3]);
  return w;
}
struct EpiProj {
  static constexpr bool PERM = true, AFTER_DRAIN = false;
  u16* FIN; f16* RW;
  __device__ __forceinline__ void operator()(const pg8::f32x4 (&acc)[2][2][4][2], const pg8::Unit& u, int wr, int wc, int fr, int fq) const {
    pg8_epi8(acc, u, wr, wc, fr, fq, [&](int row, int col, const pg8::f32x4 v0, const pg8::f32x4 v1) {
      if (col < 512) {
        *(pg8::u32x4*)(FIN + (size_t)row * 512 + col) = pk8_bf16(v0, v1);
      } else if (col < 2432) {
        f16x8 o;
#pragma unroll
        for (int j = 0; j < 4; ++j) { o[j] = f2h(v0[j]); o[4 + j] = f2h(v1[j]); }
        *(f16x8*)(RW + (size_t)row * 1920 + (col - 512)) = o;
      }
    });
  }
};
struct EpiSig {
  static constexpr bool PERM = true, AFTER_DRAIN = false;
  u16* SG;
  __device__ __forceinline__ void operator()(const pg8::f32x4 (&acc)[2][2][4][2], const pg8::Unit& u, int wr, int wc, int fr, int fq) const {
    pg8_epi8(acc, u, wr, wc, fr, fq, [&](int row, int col, pg8::f32x4 v0, pg8::f32x4 v1) {
#pragma unroll
      for (int j = 0; j < 4; ++j) { v0[j] = sigmoidf_(v0[j]); v1[j] = sigmoidf_(v1[j]); }
      *(pg8::u32x4*)(SG + (size_t)row * 2048 + col) = pk8_bf16(v0, v1);
    });
  }
};
struct EpiGate {
  static constexpr bool PERM = true, AFTER_DRAIN = false;
  u16* MG; const u16* SG; int sg_off; int add;
  __device__ __forceinline__ void operator()(const pg8::f32x4 (&acc)[2][2][4][2], const pg8::Unit& u, int wr, int wc, int fr, int fq) const {
    const int row0 = u.pm * 256 + wr * 64 + fr, col0 = u.pn * 256 + wc * 32 + 8 * fq;
#pragma unroll
    for (int ai = 0; ai < 2; ++ai) {
      u16x8 sv[4][2], ov[4][2];
#pragma unroll
      for (int m = 0; m < 4; ++m)
#pragma unroll
        for (int bj = 0; bj < 2; ++bj) {
          const int row = row0 + ai * 128 + m * 16, col = col0 + bj * 128;
          sv[m][bj] = *(const u16x8*)(SG + (size_t)row * 2048 + sg_off + col);
          if (add) ov[m][bj] = *(const u16x8*)(MG + (size_t)row * 1024 + col);
        }
#pragma unroll
      for (int m = 0; m < 4; ++m)
#pragma unroll
        for (int bj = 0; bj < 2; ++bj) {
          const int row = row0 + ai * 128 + m * 16, col = col0 + bj * 128;
          pg8::f32x4 v0 = acc[ai][bj][m][0], v1 = acc[ai][bj][m][1];
#pragma unroll
          for (int j = 0; j < 4; ++j) { v0[j] *= bf2f(sv[m][bj][j]); v1[j] *= bf2f(sv[m][bj][4 + j]); }
          if (add) {
#pragma unroll
            for (int j = 0; j < 4; ++j) { v0[j] += bf2f(ov[m][bj][j]); v1[j] += bf2f(ov[m][bj][4 + j]); }
          }
          *(pg8::u32x4*)(MG + (size_t)row * 1024 + col) = pk8_bf16(v0, v1);
        }
    }
  }
};
struct EpiResid {
  static constexpr bool PERM = false, AFTER_DRAIN = false;
  float* XL; float* XC; const float* MODg;
  const float* RL; const float* RC;
  __device__ __forceinline__ void operator()(const pg8::f32x4 (&acc)[2][2][4][2], const pg8::Unit& u, int wr, int wc, int fr, int fq) const {
    const int row0 = u.pm * 256 + wr * 64 + fr, col0 = u.pn * 256 + wc * 32 + 4 * fq;
    const bool lat = (u.pm * 256) < TL;
    const int rbase = lat ? row0 : (row0 - TL);
    const float* rd = lat ? RL : RC;
    float* wrp = lat ? XL : XC;
    const float* gp = MODg + (size_t)(lat ? ((u.pm * 256) >> 11) : 8) * 6144 + col0;
    pg8::f32x4 g[2][2];
#pragma unroll
    for (int bj = 0; bj < 2; ++bj)
#pragma unroll
      for (int n = 0; n < 2; ++n) g[bj][n] = *(const pg8::f32x4*)(gp + bj * 128 + n * 16);
#pragma unroll
    for (int ai = 0; ai < 2; ++ai) {
      pg8::f32x4 x[4][2][2];
#pragma unroll
      for (int m = 0; m < 4; ++m)
#pragma unroll
        for (int bj = 0; bj < 2; ++bj)
#pragma unroll
          for (int n = 0; n < 2; ++n)
            x[m][bj][n] = *(const pg8::f32x4*)(rd + (size_t)(rbase + ai * 128 + m * 16) * 1024 + col0 + bj * 128 + n * 16);
#pragma unroll
      for (int m = 0; m < 4; ++m)
#pragma unroll
        for (int bj = 0; bj < 2; ++bj)
#pragma unroll
          for (int n = 0; n < 2; ++n)
            *(pg8::f32x4*)(wrp + (size_t)(rbase + ai * 128 + m * 16) * 1024 + col0 + bj * 128 + n * 16) = x[m][bj][n] + g[bj][n] * acc[ai][bj][m][n];
    }
  }
};
struct EpiGateOut {
  static constexpr bool PERM = true, AFTER_DRAIN = false;
  u16* D; const float* MODg;
  __device__ __forceinline__ void operator()(const pg8::f32x4 (&acc)[2][2][4][2], const pg8::Unit& u, int wr, int wc, int fr, int fq) const {
    const int col0 = u.pn * 256 + wc * 32 + 8 * fq;
    const bool lat = (u.pm * 256) < TL;
    const float* gp = MODg + (size_t)(lat ? ((u.pm * 256) >> 11) : 8) * 6144 + col0;
    pg8::f32x4 g[2][2];
#pragma unroll
    for (int bj = 0; bj < 2; ++bj)
#pragma unroll
      for (int n = 0; n < 2; ++n) g[bj][n] = *(const pg8::f32x4*)(gp + bj * 128 + n * 4);
    pg8_epi8(acc, u, wr, wc, fr, fq, [&](int row, int col, pg8::f32x4 v0, pg8::f32x4 v1) {
      const int bj = ((col - u.pn * 256) >> 7) & 1;
      v0 *= g[bj][0]; v1 *= g[bj][1];
      *(pg8::u32x4*)(D + (size_t)row * 1024 + col) = pk8_bf16(v0, v1);
    });
  }
};
struct EpiRelu2 {
  static constexpr bool PERM = true, AFTER_DRAIN = false;
  u16* HID;
  __device__ __forceinline__ void operator()(const pg8::f32x4 (&acc)[2][2][4][2], const pg8::Unit& u, int wr, int wc, int fr, int fq) const {
    pg8_epi8(acc, u, wr, wc, fr, fq, [&](int row, int col, pg8::f32x4 v0, pg8::f32x4 v1) {
#pragma unroll
      for (int j = 0; j < 4; ++j) { const float a = fmaxf(v0[j], 0.f), b = fmaxf(v1[j], 0.f); v0[j] = a * a; v1[j] = b * b; }
      *(pg8::u32x4*)(HID + (size_t)row * 4096 + col) = pk8_bf16(v0, v1);
    });
  }
};

struct EpiDft {
  static constexpr bool PERM = true, AFTER_DRAIN = false;
  u16* FOUT; const u16* X1024;
  __device__ __forceinline__ void operator()(const pg8::f32x4 (&acc)[2][2][4][2], const pg8::Unit& u, int wr, int wc, int fr, int fq) const {
    pg8_epi8(acc, u, wr, wc, fr, fq, [&](int row, int col, pg8::f32x4 v0, pg8::f32x4 v1) {
      const float sc = 1.f / 512.f;
      const u16x8 xv = *(const u16x8*)(X1024 + col);
      const float sg = (row & 1) ? -1.f : 1.f;
#pragma unroll
      for (int j = 0; j < 4; ++j) { v0[j] += sg * bf2f(xv[j]); v1[j] += sg * bf2f(xv[4 + j]); }
      v0 *= sc; v1 *= sc;
      *(pg8::u32x4*)(FOUT + ((size_t)(col >> 9) * 2048 + row) * 512 + (col & 511)) = pk8_bf16(v0, v1);
    });
  }
};

template <class Epi>
__device__ __forceinline__ void pg8_run(char* lds, const u16* A, const u16* Bt, int M, int N, int K, const Epi& E) {
  pg8::Gemm g{A, Bt, M, N, K};
  pg8::StaticOrder S;
  S.init(M, N, (int)gridDim.x, BID());
  __syncthreads();
  pg8::gemm_phase<Epi, pg8::StaticOrder, false>((PG8_LAS unsigned char*)lds, g, S, E, nullptr);
  __syncthreads();
}

__device__ void proj_phase(const Params& p, const u16* H, char* lds) {
  EpiProj E{(u16*)(WS(p) + OFF_FIN), (f16*)(WS(p) + OFF_RW)};
  pg8_run(lds, H, (const u16*)(WS(p) + OFF_WTA + WO_IN), TA, 2560, 1024, E);
}

__device__ void dft1_phase(const Params& p, int l, char* lds) {
  const u16* FIN = (const u16*)(WS(p) + OFF_FIN);
  const u16* TW = (const u16*)(WS(p) + OFF_AR) + DM_TW;
  u16* UCS = (u16*)(WS(p) + OFF_EH);
  u16* UCSC = UCS + (size_t)32 * 256 * 2048;
  const int ntiles = 512 + (l == 0 ? 64 : 0);
  for (int tile = BID(); tile < ntiles; tile += gridDim.x) {
    const u16* bt;
    u16* o;
    int ldo;
    if (tile < 512) {
      const int bg = tile >> 4, nt = tile & 15, b = bg >> 2, g = bg & 3;
      bt = FIN + (size_t)(b * 2048 + nt * 128) * 512 + g * 128;
      o = UCS + (size_t)bg * 256 * 2048 + nt * 128;
      ldo = 2048;
    } else {
      const int t2 = tile - 512;
      const int bg = t2 >> 1, nt = t2 & 1, b = bg >> 2, g = bg & 3;
      bt = FIN + (size_t)(TL + b * 256 + nt * 128) * 512 + g * 128;
      o = UCSC + (size_t)bg * 256 * 256 + nt * 128;
      ldo = 256;
    }
    f32x4 acc[4][4];
    acc_zero(acc);
    gemm_loop(acc, TW, 128, bt, 512, 128, lds);
    if (tile < 512) {
      epi_apply(acc, lds, [&](int r, int c, float (&v)[8]) { *(u16x8*)(o + (size_t)(r & 127) * 4096 + (r >> 7) * 2048 + c) = pack_bf8(v); });
    } else {
      epi_apply(acc, lds, [&](int r, int c, float (&v)[8]) { *(u16x8*)(o + (size_t)r * ldo + c) = pack_bf8(v); });
    }
  }
}

__device__ void fold_phase(const Params& p) {
  const u16* UCS = (const u16*)(WS(p) + OFF_EH);
  u16* EO = (u16*)(WS(p) + OFF_EO);
  u16* X = (u16*)(WS(p) + OFF_X1024);
  const int lane = TID() & 63;
  const int gw = BID() * 8 + (TID() >> 6), nw_ = gridDim.x * 8;
  for (int it = gw; it < 4096 * 2; it += nw_) {
    const int n = it >> 1, ci = (it & 1) * 64 + lane;
    const u16* uc = UCS + (size_t)n * 4096;
    const u16* us = uc + 2048;
    const u16x8 cf = *(const u16x8*)(uc + ci * 8), sf = *(const u16x8*)(us + ci * 8);
    const u16x8 ca = *(const u16x8*)(uc + (255 - ci) * 8), sa = *(const u16x8*)(us + (255 - ci) * 8);
    const int cb = (ci == 0) ? 255 : (256 - ci);
    const u16x8 cbv = *(const u16x8*)(uc + cb * 8), sbv = *(const u16x8*)(us + cb * 8);
    float e[8], o[8];
#pragma unroll
    for (int j = 0; j < 8; ++j) {
      const float c = bf2f(cf[j]), sn = bf2f(sf[j]);
      const float cm = (j == 0) ? bf2f(cbv[0]) : bf2f(ca[8 - j]);
      const float sm = (j == 0) ? bf2f(sbv[0]) : bf2f(sa[8 - j]);
      e[j] = c + cm;
      o[j] = sn - sm;
    }
    if (ci == 0) { e[0] = bf2f(cf[0]); o[0] = 0.f; }
    *(u16x8*)(EO + (size_t)n * 2048 + ci * 8) = pack_bf8(e);
    *(u16x8*)(EO + (size_t)n * 2048 + 1024 + ci * 8) = pack_bf8(o);
    if (ci == 0) X[n] = uc[1024];
  }
}

__device__ void dft2_phase(const Params& p, int l, char* lds) {
  const u16* DM = (const u16*)(WS(p) + OFF_AR);
  const u16* UCS = (const u16*)(WS(p) + OFF_EH);
  const u16* UCSC = UCS + (size_t)32 * 256 * 2048;
  u16* FOUT = (u16*)(WS(p) + OFF_FIN);
  EpiDft E{FOUT, (const u16*)(WS(p) + OFF_X1024)};
  pg8_run(lds, DM, (const u16*)(WS(p) + OFF_EO), 2048, 4096, 2048, E);
  const int hb = BID() - 128;
  if (hb >= 0) {
    if (l == 0) {
      for (int t2 = hb; t2 < 32; t2 += 128) {
        const int b = t2 >> 2, g = t2 & 3;
        const u16* bt = UCSC + (size_t)((b * 4 + g) * 256) * 256;
        u16* o = FOUT + (size_t)(TL + b * 256) * 512 + g * 128;
        const float sc = 0.005524271728019903f;
        f32x4 acc[4][4];
        acc_zero(acc);
#pragma unroll 1
        for (int seg = 0; seg < 2; ++seg)
          gemm_loop(acc, seg == 0 ? DM + DM_CC : DM + DM_NSC, 256, bt + (size_t)seg * 128 * 256, 256, 256, lds);
        epi_apply(acc, lds, [&](int r, int c, float (&v)[8]) {
#pragma unroll
          for (int j = 0; j < 8; ++j) v[j] *= sc;
          *(u16x8*)(o + (size_t)r * 512 + c) = pack_bf8(v);
        });
      }
    }
    conv_phase(p, l, 1, lds, hb, 128);
  }
}

__device__ void lora_phase(const Params& p, int l, char* lds) {
  const u16* LORA = (const u16*)(WS(p) + OFF_LORA);
  const u16* WupT = (const u16*)(WS(p) + OFF_WTA + WO_WUP);
  const u16* AupT = (const u16*)(WS(p) + OFF_WTA + WO_AUP);
  constexpr int MT = TA / 256;
  constexpr int total = 4 * MT * 4;
  const int tid = TID();
  const int lane = tid & 63, wave = tid >> 6;
  const int wm = wave >> 1, wn = wave & 1;
  u16* s0 = (u16*)lds;
  const int lr = tid >> 3, lc = (tid & 7) * 8;
  const int wofa = lr * LDT + lc, wofb = 256 * LDT + wofa;
  const int arow = (wm * 64 + (lane & 15)) * LDT + (lane >> 4) * 8;
  const int brow = (wn * 64 + (lane & 15)) * LDT + (lane >> 4) * 8;
  const int G = (int)gridDim.x;
  int tile = BID();
  if (tile >= total) return;
  uint4 ra0, ra1, ra2, ra3, rb0, rb1;
#define LORA_LOAD(tl) do { const int wh_ = (tl) / (MT * 4), rm_ = (tl) % (MT * 4), mt_ = rm_ >> 2, nt_ = rm_ & 3; \
    const u16* ap_ = LORA + (size_t)mt_ * 256 * 256 + wh_ * 64 + (size_t)lr * 256 + lc; \
    const u16* bp_ = (wh_ < 2 ? WupT : AupT) + (size_t)(wh_ & 1) * 512 * 64 + (size_t)nt_ * 128 * 64 + (size_t)lr * 64 + lc; \
    ra0 = *(const uint4*)ap_; ra1 = *(const uint4*)(ap_ + 64 * 256); ra2 = *(const uint4*)(ap_ + 128 * 256); ra3 = *(const uint4*)(ap_ + 192 * 256); \
    rb0 = *(const uint4*)bp_; rb1 = *(const uint4*)(bp_ + 64 * 64); } while (0)
  LORA_LOAD(tile);
  for (; tile < total; tile += G) {
    const int which = tile / (MT * 4), rem = tile % (MT * 4), mt = rem >> 2, nt = rem & 3;
    const int d = which & 1;
    __syncthreads();
    *(uint4*)(s0 + wofa) = ra0;
    *(uint4*)(s0 + wofa + 64 * LDT) = ra1;
    *(uint4*)(s0 + wofa + 128 * LDT) = ra2;
    *(uint4*)(s0 + wofa + 192 * LDT) = ra3;
    *(uint4*)(s0 + wofb) = rb0;
    *(uint4*)(s0 + wofb + 64 * LDT) = rb1;
    __syncthreads();
    if (tile + G < total) LORA_LOAD(tile + G);
    f32x4 acc[4][4];
    acc_zero(acc);
    {
      const u16* sa = s0;
      const u16* sb = s0 + 256 * LDT;
#define MF(i, j, av, bv) acc[i][j] = __builtin_amdgcn_mfma_f32_16x16x32_bf16(av, bv, acc[i][j], 0, 0, 0)
#pragma unroll
      for (int ks = 0; ks < 2; ++ks) {
        const bf16x8 a0 = *(const bf16x8*)(sa + arow + ks * 32);
        const bf16x8 a1 = *(const bf16x8*)(sa + arow + 16 * LDT + ks * 32);
        const bf16x8 a2 = *(const bf16x8*)(sa + arow + 32 * LDT + ks * 32);
        const bf16x8 a3 = *(const bf16x8*)(sa + arow + 48 * LDT + ks * 32);
        const bf16x8 b0 = *(const bf16x8*)(sb + brow + ks * 32);
        const bf16x8 b1 = *(const bf16x8*)(sb + brow + 16 * LDT + ks * 32);
        const bf16x8 b2 = *(const bf16x8*)(sb + brow + 32 * LDT + ks * 32);
        const bf16x8 b3 = *(const bf16x8*)(sb + brow + 48 * LDT + ks * 32);
        MF(0, 0, a0, b0); MF(0, 1, a0, b1); MF(0, 2, a0, b2); MF(0, 3, a0, b3);
        MF(1, 0, a1, b0); MF(1, 1, a1, b1); MF(1, 2, a1, b2); MF(1, 3, a1, b3);
        MF(2, 0, a2, b0); MF(2, 1, a2, b1); MF(2, 2, a2, b2); MF(2, 3, a2, b3);
        MF(3, 0, a3, b0); MF(3, 1, a3, b1); MF(3, 2, a3, b2); MF(3, 3, a3, b3);
      }
#undef MF
    }
    __syncthreads();
    f16* o = (f16*)(WS(p) + (which < 2 ? OFF_EH : OFF_AR)) + (size_t)d * TA * 512 + (size_t)mt * 256 * 512 + nt * 128;
    const float* bias = (which < 2 ? p.w0 : p.a0) + (size_t)l * 1024 + d * 512 + nt * 128;
    const float mul = (which < 2) ? 0.6065306597126334f : 1.f;
    epi_apply(acc, lds, [&](int r, int c, float (&v)[8]) {
      const float4 b0 = *(const float4*)(bias + c), b1 = *(const float4*)(bias + c + 4);
      const float bb[8] = {b0.x, b0.y, b0.z, b0.w, b1.x, b1.y, b1.z, b1.w};
#pragma unroll
      for (int j = 0; j < 8; ++j) v[j] = sigmoidf_(bb[j] + v[j]) * mul;
      *(f16x8*)(o + (size_t)r * 512 + c) = pack_h8(v);
    });
  }
#undef LORA_LOAD
  __syncthreads();
}

__device__ void g_phase(const Params& p, int ntok, char* lds) {
  const u16* GDS = (const u16*)(WS(p) + OFF_GDS);
  const u16* GupT = (const u16*)(WS(p) + OFF_WTA + WO_GUP);
  u16* Z = (u16*)(WS(p) + OFF_YS0);
  const int MT = ntok / 256;
  for (int tile = BID(); tile < MT * 4; tile += gridDim.x) {
    const int mt = tile >> 2, nt = tile & 3;
    f32x4 acc[4][4];
    acc_zero(acc);
    u16* o = Z + (size_t)mt * 256 * 512 + nt * 128;
    const int lane_ = TID() & 63, wave_ = TID() >> 6;
    const int wm_ = wave_ >> 1, wn_ = wave_ & 1;
    u16x8 zp[2][4];
#pragma unroll
    for (int hp = 0; hp < 2; ++hp)
#pragma unroll
      for (int i = 0; i < 4; ++i)
        zp[hp][i] = *(const u16x8*)(o + (size_t)(wm_ * 64 + hp * 32 + i * 8 + (lane_ >> 3)) * 512 + wn_ * 64 + (lane_ & 7) * 8);
    gemm_loop(acc, GDS + (size_t)mt * 256 * 128, 128, GupT + (size_t)nt * 128 * 128, 128, 128, lds);
    {
      float* sw = (float*)lds + wave_ * (32 * 68);
#pragma unroll
      for (int hp = 0; hp < 2; ++hp) {
#pragma unroll
        for (int m2 = 0; m2 < 2; ++m2)
#pragma unroll
          for (int nf = 0; nf < 4; ++nf)
#pragma unroll
            for (int r = 0; r < 4; ++r)
              sw[(m2 * 16 + (lane_ >> 4) * 4 + r) * 68 + nf * 16 + (lane_ & 15)] = acc[hp * 2 + m2][nf][r];
        __builtin_amdgcn_wave_barrier();
#pragma unroll
        for (int i = 0; i < 4; ++i) {
          const int rr = i * 8 + (lane_ >> 3), cc = (lane_ & 7) * 8;
          const float4 a = *(const float4*)(sw + rr * 68 + cc), b = *(const float4*)(sw + rr * 68 + cc + 4);
          float v[8] = {a.x, a.y, a.z, a.w, b.x, b.y, b.z, b.w};
#pragma unroll
          for (int j = 0; j < 8; ++j) v[j] *= bf2f(zp[hp][i][j]);
          *(u16x8*)(o + (size_t)(wm_ * 64 + hp * 32 + rr) * 512 + wn_ * 64 + cc) = pack_bf8(v);
        }
        __builtin_amdgcn_wave_barrier();
      }
    }
  }
}

__device__ void gates_phase(const Params& p, const u16* H, int ntok, char* lds) {
  EpiSig E{(u16*)(WS(p) + OFF_YS1)};
  pg8_run(lds, H, (const u16*)(WS(p) + OFF_WTA + WO_IN) + (size_t)2432 * 1024, ntok, 2048, 1024, E);
}
__device__ void merge_phase(const Params& p, int ntok, char* lds) {
  u16* MG = (u16*)(WS(p) + OFF_AR);
  const u16* SG = (const u16*)(WS(p) + OFF_YS1);
  EpiGate E0{MG, SG, 0, 0};
  pg8_run(lds, (const u16*)(WS(p) + OFF_FIN), (const u16*)(WS(p) + OFF_WTA + WO_FU), ntok, 1024, 512, E0);
  EpiGate E1{MG, SG, 1024, 1};
  pg8_run(lds, (const u16*)(WS(p) + OFF_YS0), (const u16*)(WS(p) + OFF_WTA + WO_RU), ntok, 1024, 512, E1);
}
__device__ void resid_gemm_phase(const Params& p, int l, int ntok, const u16* A, int K, const u16* Bt, int gate_off, bool from_inputs, char* lds) {
  float* XC = (float*)(WS(p) + OFF_XC);
  EpiResid E{p.out, XC, (const float*)(WS(p) + OFF_MOD) + (size_t)l * 9 * 6144 + gate_off,
             from_inputs ? p.x : (const float*)p.out, from_inputs ? p.ctx : (const float*)XC};
  pg8_run(lds, A, Bt, ntok, 1024, K, E);
}

__device__ void mlp_down_ctx_phase(const Params& p, char* lds) {
  const u16* HID = (const u16*)(WS(p) + OFF_HID) + (size_t)TL * 4096;
  const u16* W2T = (const u16*)(WS(p) + OFF_W2T);
  u16* PART = (u16*)(WS(p) + OFF_FIN);
  for (int item = BID(); item < 256; item += gridDim.x) {
    const int ks = item & 3, nt = (item >> 2) & 7, mt = item >> 5;
    f32x4 acc[4][4];
    acc_zero(acc);
    gemm_loop(acc, HID + (size_t)mt * 256 * 4096 + ks * 1024, 4096, W2T + (size_t)nt * 128 * 4096 + ks * 1024, 4096, 1024, lds);
    u16* o = PART + ((size_t)ks * 2048 + mt * 256) * 1024 + nt * 128;
    epi_apply(acc, lds, [&](int r, int c, float (&v)[8]) { *(u16x8*)(o + (size_t)r * 1024 + c) = pack_bf8(v); });
  }
}

__device__ void out_ctx_phase(const Params& p, char* lds) {
  const u16* MG = (const u16*)(WS(p) + OFF_AR) + (size_t)TL * 1024;
  const u16* WoutT = (const u16*)(WS(p) + OFF_WTA + WO_OUT);
  u16* PART = (u16*)(WS(p) + OFF_FIN);
  const float* g1 = (const float*)(WS(p) + OFF_MOD) + (size_t)8 * 6144 + 2048;
  for (int item = BID(); item < 256; item += gridDim.x) {
    const int ks = item & 3, nt = (item >> 2) & 7, mt = item >> 5;
    f32x4 acc[4][4];
    acc_zero(acc);
    gemm_loop(acc, MG + (size_t)mt * 256 * 1024 + ks * 256, 1024, WoutT + (size_t)nt * 128 * 1024 + ks * 256, 1024, 256, lds);
    u16* o = PART + ((size_t)ks * 2048 + mt * 256) * 1024 + nt * 128;
    const float* gg = g1 + nt * 128;
    epi_apply(acc, lds, [&](int r, int c, float (&v)[8]) {
      const float4 ga = *(const float4*)(gg + c), gb = *(const float4*)(gg + c + 4);
      v[0] *= ga.x; v[1] *= ga.y; v[2] *= ga.z; v[3] *= ga.w; v[4] *= gb.x; v[5] *= gb.y; v[6] *= gb.z; v[7] *= gb.w;
      *(u16x8*)(o + (size_t)r * 1024 + c) = pack_bf8(v);
    });
  }
}

__device__ void mlp_up_phase(const Params& p, int ntok, char* lds) {
  EpiRelu2 E{(u16*)(WS(p) + OFF_HID)};
  pg8_run(lds, (const u16*)(WS(p) + OFF_EH), (const u16*)(WS(p) + OFF_W1T), ntok, 4096, 1024, E);
}

#define XB_TMO      128
#define XB_XCNT(j)  (256  + 64 * (j))
#define XB_XSUB(j)  (1280 + 64 * (j))
#define XB_XGEN(j)  (2304 + 64 * (j))
#define XB_TOP      3328
#define XB_TOPGEN   3392
#define XCD_BAR_WORDS 3456
#define XB_SPIN_CAP (1u << 18)
#define LAS __attribute__((address_space(3)))

__device__ __forceinline__ unsigned xb_ld(unsigned* p)              { return __hip_atomic_load(p, __ATOMIC_RELAXED, __HIP_MEMORY_SCOPE_AGENT); }
__device__ __forceinline__ unsigned xb_add(unsigned* p, unsigned v) { return __hip_atomic_fetch_add(p, v, __ATOMIC_RELAXED, __HIP_MEMORY_SCOPE_AGENT); }
__device__ __forceinline__ unsigned xb_xcc_id() { return (unsigned)__builtin_amdgcn_s_getreg((3 << 11) | 20) & 0xFu; }
#define XB_SPIN(cond, bar) do { unsigned _sp = 0; while (cond) { __builtin_amdgcn_s_sleep(1); \
    if ((++_sp & 255u) == 0u) { if (xb_ld(&(bar)[XB_TMO])) break; if (_sp > XB_SPIN_CAP) { atomicAdd(&(bar)[XB_TMO], 1u); break; } } } } while (0)

struct XcdBarrier { unsigned* bar; unsigned x; volatile LAS unsigned* st; };

__device__ __forceinline__ XcdBarrier xcd_barrier_post(unsigned* bar, volatile LAS unsigned* st) {
    XcdBarrier b; b.bar = bar; b.x = xb_xcc_id(); b.st = st;
    if (threadIdx.x == 0) (void)xb_add(&bar[XB_XCNT(b.x)], 1u);
    return b;
}
__device__ __forceinline__ void xcd_barrier_complete(unsigned* bar, unsigned x, unsigned& nloc, unsigned& nx) {
    const unsigned G = gridDim.x * gridDim.y * gridDim.z;
    unsigned sum, cnt, mine, sp = 0u;
    for (;;) {
        sum = 0u; cnt = 0u; mine = 0u;
#pragma unroll
        for (unsigned j = 0; j < 16; ++j) { const unsigned c = xb_ld(&bar[XB_XCNT(j)]); sum += c; cnt += (c > 0u) ? 1u : 0u; mine = (j == x) ? c : mine; }
        if (sum == G) break;
        __builtin_amdgcn_s_sleep(1);
        if ((++sp & 255u) == 0u) { if (xb_ld(&bar[XB_TMO])) break; if (sp > XB_SPIN_CAP) { atomicAdd(&bar[XB_TMO], 1u); break; } }
    }
    nloc = mine > 0u ? mine : 1u; nx = cnt > 0u ? cnt : 1u;
}
__device__ __forceinline__ void xcd_barrier(const XcdBarrier& b) {
    asm volatile("s_waitcnt vmcnt(0)" ::: "memory");
    __syncthreads();
    if (threadIdx.x == 0) {
        int bz = 0; asm volatile("" : "+s"(bz));
        unsigned* bar = b.bar + bz;
        __builtin_amdgcn_s_waitcnt(0);
        unsigned nloc = b.st[0], nx = b.st[1];
        if (nloc == 0u) { xcd_barrier_complete(bar, b.x, nloc, nx); b.st[0] = nloc; b.st[1] = nx; }
        const unsigned old = xb_add(&bar[XB_XSUB(b.x)], 1u);
        const unsigned gen = old / nloc;
        if (old + 1u == (gen + 1u) * nloc) {
            __builtin_amdgcn_fence(__ATOMIC_RELEASE, "agent");
            asm volatile("s_waitcnt vmcnt(0)" ::: "memory");
            const unsigned og = xb_add(&bar[XB_TOP], 1u);
            const unsigned tg = og / nx;
            if (og + 1u == (tg + 1u) * nx) xb_add(&bar[XB_TOPGEN], 1u);
            else XB_SPIN(xb_ld(&bar[XB_TOPGEN]) == tg, bar);
            __builtin_amdgcn_fence(__ATOMIC_ACQUIRE, "agent");
            xb_add(&bar[XB_XGEN(b.x)], 1u);
            asm volatile("s_waitcnt vmcnt(0)" ::: "memory");
        } else {
            XB_SPIN(xb_ld(&bar[XB_XGEN(b.x)]) == gen, bar);
            __builtin_amdgcn_fence(__ATOMIC_ACQUIRE, "agent");
            asm volatile("s_waitcnt vmcnt(0)" ::: "memory");
        }
    }
    __syncthreads();
}

constexpr int PH_PER_LAYER = 14;
constexpr int N_PHASES = 1 + 2 * PH_PER_LAYER + 1;

typedef const __attribute__((address_space(4))) Params* KParamsPtr;
__device__ __forceinline__ void run_phase(int ph, char* lds) {
#if defined(__HIP_DEVICE_COMPILE__)
  int kz = 0; asm volatile("" : "+s"(kz));
  const Params p = *(KParamsPtr)((const __attribute__((address_space(4))) char*)__builtin_amdgcn_kernarg_segment_ptr() + kz);
#else
  const Params p{};
#endif
  if (ph == 0) {
    mod_phase(p, lds);
    return;
  }
  if (ph == N_PHASES - 1) { final_norm(p); return; }
  const int l = (ph - 1) / PH_PER_LAYER, q = (ph - 1) % PH_PER_LAYER;
  const int ntok = (l == 0) ? TA : TL;
  u16* Hbuf = (l == 0) ? (u16*)p.out : (u16*)(WS(p) + OFF_EH);
  switch (q) {
    case 0:
      conv_phase(p, l, 0, lds);
      dftm_gen(p, lds);
      normmod_phase(p, l, 0, TA, Hbuf, l == 0, nullptr, (l == 1) ? (const u16*)(WS(p) + OFF_FIN) : nullptr,
                    (const float*)(WS(p) + OFF_MOD) + (size_t)8 * 6144 + 5120);
      break;
    case 1: proj_phase(p, Hbuf, lds); break;
    case 2: dft1_phase(p, l, lds); prep3a_phase(p, l); break;
    case 3: fold_phase(p); break;
    case 4: dft2_phase(p, l, lds); break;
    case 5: lora_phase(p, l, lds); break;
    case 6: scan_phase(p, l, lds); break;
    case 7:
      post5a_phase(p, l, ntok);
      if (l != 0) normmod_phase(p, l, 0, ntok, Hbuf, false);
      break;
    case 8: g_phase(p, ntok, lds); gates_phase(p, Hbuf, ntok, lds); break;
    case 9: merge_phase(p, ntok, lds); break;
    case 10: {
      EpiGateOut E{(u16*)(WS(p) + OFF_YS1), (const float*)(WS(p) + OFF_MOD) + (size_t)l * 9 * 6144 + 2048};
      if (l == 0) out_ctx_phase(p, lds);
      pg8_run(lds, (const u16*)(WS(p) + OFF_AR), (const u16*)(WS(p) + OFF_WTA + WO_OUT), TL, 1024, 1024, E);
    } break;
    case 11: normmod_phase(p, l, 1, ntok, (u16*)(WS(p) + OFF_EH), l == 0, (const u16*)(WS(p) + OFF_YS1),
                           (l == 0) ? (const u16*)(WS(p) + OFF_FIN) : nullptr); break;
    case 12: mlp_up_phase(p, ntok, lds); break;
    case 13:
      if (l == 0) {
        mlp_down_ctx_phase(p, lds);
        resid_gemm_phase(p, l, TL, (const u16*)(WS(p) + OFF_HID), 4096, (const u16*)(WS(p) + OFF_W2T), 5120, false, lds);
      } else {
        EpiGateOut E{(u16*)(WS(p) + OFF_EH), (const float*)(WS(p) + OFF_MOD) + (size_t)l * 9 * 6144 + 5120};
        pg8_run(lds, (const u16*)(WS(p) + OFF_HID), (const u16*)(WS(p) + OFF_W2T), TL, 1024, 4096, E);
      }
      break;
  }
}

extern "C" __global__ void __launch_bounds__(NTHREADS) fwd_megakernel(Params p) {
  extern __shared__ __attribute__((aligned(16))) char lds[];
#if ONE_LAUNCH
  cg::grid_group grid = cg::this_grid();
  if (threadIdx.x == 0) *(uint4*)(lds + LDS_STAGE_BYTES) = make_uint4(0u, 0u, 0u, 0u);
  __syncthreads();
  XcdBarrier xb = xcd_barrier_post((unsigned*)(p.ws + OFF_BAR), (volatile LAS unsigned*)(lds + LDS_STAGE_BYTES));
#ifndef REP_MASK
#define REP_MASK 0
#endif
  int ph = p.ph_lo, rep = 0;
  while (ph < p.ph_hi) {
    run_phase(ph, lds);
    const bool first = (ph == p.ph_lo) && (rep == 0);
    const bool again = (rep == 0) && ph >= 1 && ph < N_PHASES - 1 && ((REP_MASK >> ((ph - 1) % PH_PER_LAYER)) & 1);
    if (again) rep = 1; else { rep = 0; ++ph; }
    if (ph < p.ph_hi) {
      if (first && p.ph_hi < 0) grid.sync();
      else xcd_barrier(xb);
    }
  }
#else
  for (int ph = p.ph_lo; ph < p.ph_hi; ++ph) run_phase(ph, lds);
#endif
}

extern "C" void kernel_launch(void* const* d_in, const int* in_sizes, int n_in, void* d_out, int out_size, void* d_ws,
                              size_t ws_size, hipStream_t stream) {
  static int grid = 0;
  if (grid == 0) {
    if (ws_size < WS_NEED) { fprintf(stderr, "kernel_launch: workspace too small: %zu < %zu\n", ws_size, (size_t)WS_NEED); grid = -1; return; }
    int dev = 0, cus = 0, per_cu = 0;
    hipGetDevice(&dev);
    hipDeviceGetAttribute(&cus, hipDeviceAttributeMultiprocessorCount, dev);
    hipFuncSetAttribute((const void*)fwd_megakernel, hipFuncAttributeMaxDynamicSharedMemorySize, LDS_BYTES);
    hipOccupancyMaxActiveBlocksPerMultiprocessor(&per_cu, (const void*)fwd_megakernel, NTHREADS, LDS_BYTES);
    if (per_cu < 1) per_cu = 1;
    grid = cus;
    (void)hipGetLastError();
  }
  if (grid < 0) return;
  Params p{};
  const float** pp = (const float**)&p;
  for (int i = 0; i < 26; ++i) pp[i] = (const float*)d_in[i];
  p.out = (float*)d_out;
  p.ws = (char*)d_ws;
#if ONE_LAUNCH
  (void)hipMemsetAsync((char*)d_ws + OFF_BAR, 0, XCD_BAR_WORDS * sizeof(unsigned), stream);
  p.ph_lo = 0; p.ph_hi = N_PHASES;
  void* args[] = {&p};
  hipError_t e = hipLaunchCooperativeKernel((const void*)fwd_megakernel, dim3(grid), dim3(NTHREADS), args, LDS_BYTES, stream);
  if (e != hipSuccess) fprintf(stderr, "cooperative launch failed: %s (grid %d)\n", hipGetErrorString(e), grid);
#else
  for (int ph = 0; ph < N_PHASES; ++ph) {
    p.ph_lo = ph; p.ph_hi = ph + 1;
    hipLaunchKernelGGL(fwd_megakernel, dim3(grid), dim3(NTHREADS), LDS_BYTES, stream, p);
  }
#endif
}
```
